# Optimizing an MI355X kernel written in HIP

```python
import math
import jax
import jax.numpy as jnp
from jax import lax
import numpy as np

D_MODEL = 1024
BATCH = 2
SEQ = 8192
DEPTH = 2


HEAD_DIM = 64
N_HEADS = D_MODEL // HEAD_DIM
MEM_LEN = 256
MEM_HEADS = 4
SB_HEADS = (N_HEADS - MEM_HEADS) // 2
DIFF_HEADS = (N_HEADS - MEM_HEADS) // 2
DIFF_QK_DIM = HEAD_DIM // 2
DIFF_V_DIM = 2 * DIFF_QK_DIM
SWA_Q_HEADS = N_HEADS - MEM_HEADS
SWA_KV_HEADS = SWA_Q_HEADS // 4
SWA_GROUP = SWA_Q_HEADS // SWA_KV_HEADS
WINDOW = 128
BLOCK = 128
ROPE_THETA = 500000.0
ROPE_FRACTION = 4
MIX_WIDTH = N_HEADS * HEAD_DIM
DEEPNORM_ALPHA = (2 * DEPTH) ** 0.25
DEEPNORM_BETA = (8 * DEPTH) ** -0.25
LN_EPS = 1e-5
NEG_BIG = -1e30
N_EVEN = (DEPTH + 1) // 2
N_ODD = DEPTH // 2

EVEN_WIDTHS = (SB_HEADS * HEAD_DIM, SB_HEADS * HEAD_DIM, SB_HEADS * HEAD_DIM,
               DIFF_HEADS * 2 * DIFF_QK_DIM, DIFF_HEADS * 2 * DIFF_QK_DIM, DIFF_HEADS * DIFF_V_DIM,
               MEM_HEADS * HEAD_DIM, MIX_WIDTH)
EVEN_VALUE_SLOTS = (2, 5)
ODD_WIDTHS = (SWA_Q_HEADS * HEAD_DIM, SWA_KV_HEADS * HEAD_DIM, SWA_KV_HEADS * HEAD_DIM,
              MEM_HEADS * HEAD_DIM, MIX_WIDTH)
ODD_VALUE_SLOTS = (2,)
EVEN_IN = sum(EVEN_WIDTHS)
ODD_IN = sum(ODD_WIDTHS)

kernel_name = 'hybrid_stickbreak_diff_swa_memory_deepnorm'


def _split(h, widths):
    outs = []
    start = 0
    for w in widths:
        outs.append(h[..., start:start + w])
        start += w
    return outs


def _layer_norm(x, g, b):
    xf = x.astype(jnp.float32)
    mu = jnp.mean(xf, axis=-1, keepdims=True)
    var = jnp.mean(jnp.square(xf - mu), axis=-1, keepdims=True)
    y = (xf - mu) * lax.rsqrt(var + LN_EPS) * g.astype(jnp.float32) + b.astype(jnp.float32)
    return y.astype(x.dtype)


def _rms_norm(x, g):
    xf = x.astype(jnp.float32)
    y = xf * lax.rsqrt(jnp.mean(jnp.square(xf), axis=-1, keepdims=True) + LN_EPS) * g.astype(jnp.float32)
    return y.astype(x.dtype)


def _partial_rope(x, positions):
    rot = x.shape[-1] // ROPE_FRACTION
    half = rot // 2
    inv_freq = jnp.exp(-(jnp.arange(half, dtype=jnp.float32) / half) * math.log(ROPE_THETA))
    ang = positions.astype(jnp.float32)[:, :, None] * inv_freq[None, None, :]
    new_shape = (ang.shape[0], ang.shape[1]) + (1,) * (x.ndim - 3) + (half,)
    ang = ang.reshape(new_shape)
    cos = jnp.cos(ang).astype(x.dtype)
    sin = jnp.sin(ang).astype(x.dtype)
    x1 = x[..., :half]
    x2 = x[..., half:rot]
    rest = x[..., rot:]
    return jnp.concatenate([x1 * cos - x2 * sin, x2 * cos + x1 * sin, rest], axis=-1)


def _block_outputs(out):
    out = jnp.moveaxis(out, 0, 1)
    return out.reshape((out.shape[0], out.shape[1] * out.shape[2]) + out.shape[3:])


def _stick_breaking_attention(q, k, v):
    s_len, d = q.shape[1], q.shape[-1]
    nb = s_len // BLOCK
    key_idx = jnp.arange(s_len, dtype=jnp.int32)
    scale = d ** -0.5

    def one_block(bi):
        qi = lax.dynamic_slice_in_dim(q, bi * BLOCK, BLOCK, axis=1)
        z = jnp.einsum('bqhd,bkhd->bhqk', qi, k, preferred_element_type=jnp.float32) * scale
        q_idx = bi * BLOCK + jnp.arange(BLOCK, dtype=jnp.int32)
        strict = key_idx[None, :] < q_idx[:, None]
        log_1mb = jnp.where(strict, jax.nn.log_sigmoid(-z), 0.0)
        rc = jnp.flip(jnp.cumsum(jnp.flip(log_1mb, axis=-1), axis=-1), axis=-1)
        after = rc - log_1mb
        w = jnp.where(strict, jnp.exp(jax.nn.log_sigmoid(z) + after), 0.0)
        return jnp.einsum('bhqk,bkhd->bqhd', w.astype(v.dtype), v)

    out = lax.map(one_block, jnp.arange(nb, dtype=jnp.int32))
    return _block_outputs(out)


def _differential_attention(q, k, v, lam):
    s_len, d = q.shape[1], q.shape[-1]
    nb = s_len // BLOCK
    key_idx = jnp.arange(s_len, dtype=jnp.int32)
    scale = d ** -0.5

    def one_block(bi):
        qi = lax.dynamic_slice_in_dim(q, bi * BLOCK, BLOCK, axis=1)
        s = jnp.einsum('bqhcd,bkhcd->bhcqk', qi, k, preferred_element_type=jnp.float32) * scale
        q_idx = bi * BLOCK + jnp.arange(BLOCK, dtype=jnp.int32)
        causal = key_idx[None, :] <= q_idx[:, None]
        p = jax.nn.softmax(jnp.where(causal, s, NEG_BIG), axis=-1)
        a = p[:, :, 0] - lam * p[:, :, 1]
        return jnp.einsum('bhqk,bkhd->bqhd', a.astype(v.dtype), v)

    out = lax.map(one_block, jnp.arange(nb, dtype=jnp.int32))
    return _block_outputs(out)


def _sliding_window_attention(q, k, v, sinks):
    b, s_len = q.shape[0], q.shape[1]
    d = q.shape[-1]
    nb = s_len // BLOCK
    scale = d ** -0.5
    pad = jnp.zeros((b, BLOCK) + k.shape[2:], k.dtype)
    kp = jnp.concatenate([pad, k], axis=1)
    vp = jnp.concatenate([pad.astype(v.dtype), v], axis=1)
    sink = sinks.astype(jnp.float32).reshape(SWA_KV_HEADS, SWA_GROUP)[None, :, :, None, None]
    offs_q = jnp.arange(BLOCK, dtype=jnp.int32)
    offs_k = jnp.arange(2 * BLOCK, dtype=jnp.int32) - BLOCK
    rel = offs_k[None, :] - offs_q[:, None]

    def one_block(bi):
        qi = lax.dynamic_slice_in_dim(q, bi * BLOCK, BLOCK, axis=1)
        kb = lax.dynamic_slice_in_dim(kp, bi * BLOCK, 2 * BLOCK, axis=1)
        vb = lax.dynamic_slice_in_dim(vp, bi * BLOCK, 2 * BLOCK, axis=1)
        s = jnp.einsum('bqhgd,bkhd->bhgqk', qi, kb, preferred_element_type=jnp.float32) * scale
        k_pos = bi * BLOCK + offs_k
        band = (rel <= 0) & (rel > -WINDOW) & (k_pos[None, :] >= 0)
        s = jnp.where(band, s, NEG_BIG)
        m = jnp.maximum(jnp.max(s, axis=-1, keepdims=True), sink)
        p = jnp.exp(s - m)
        w = p / (jnp.sum(p, axis=-1, keepdims=True) + jnp.exp(sink - m))
        return jnp.einsum('bhgqk,bkhd->bqhgd', w.astype(vb.dtype), vb)

    out = lax.map(one_block, jnp.arange(nb, dtype=jnp.int32))
    return _block_outputs(out)


def _memory_attention(q, mem, w_memkv):
    b, s_len = q.shape[0], q.shape[1]
    m_len = mem.shape[1]
    q = q.reshape(b, s_len, MEM_HEADS, HEAD_DIM)
    kv = mem @ w_memkv
    mk = kv[..., :MEM_HEADS * HEAD_DIM].reshape(b, m_len, MEM_HEADS, HEAD_DIM)
    mv = kv[..., MEM_HEADS * HEAD_DIM:].reshape(b, m_len, MEM_HEADS, HEAD_DIM)
    s = jnp.einsum('bshd,bmhd->bhsm', q, mk, preferred_element_type=jnp.float32) * (HEAD_DIM ** -0.5)
    p = jax.nn.softmax(s, axis=-1)
    return jnp.einsum('bhsm,bmhd->bshd', p.astype(mv.dtype), mv)


def _even_layer(x, mem, positions, w_in, w_memkv, diff_lambda, diff_subln, w_out, ln_g, ln_b, layer_idx):
    b, s_len = x.shape[0], x.shape[1]
    h = x @ w_in
    sb_q, sb_k, sb_v, df_q, df_k, df_v, m_q, gate = _split(h, EVEN_WIDTHS)
    sb_o = _stick_breaking_attention(sb_q.reshape(b, s_len, SB_HEADS, HEAD_DIM),
                                     sb_k.reshape(b, s_len, SB_HEADS, HEAD_DIM),
                                     sb_v.reshape(b, s_len, SB_HEADS, HEAD_DIM))
    lambda_init = 0.8 - 0.6 * math.exp(-0.3 * layer_idx)
    dl = diff_lambda.astype(jnp.float32)
    lam = jnp.exp(jnp.sum(dl[0] * dl[1])) - jnp.exp(jnp.sum(dl[2] * dl[3])) + lambda_init
    df_q = _partial_rope(df_q.reshape(b, s_len, DIFF_HEADS, 2, DIFF_QK_DIM), positions)
    df_k = _partial_rope(df_k.reshape(b, s_len, DIFF_HEADS, 2, DIFF_QK_DIM), positions)
    df_o = _differential_attention(df_q, df_k, df_v.reshape(b, s_len, DIFF_HEADS, DIFF_V_DIM), lam)
    df_o = _rms_norm(df_o, diff_subln) * (1.0 - lambda_init)
    mem_o = _memory_attention(m_q, mem, w_memkv)
    mixed = jnp.concatenate([sb_o.reshape(b, s_len, SB_HEADS * HEAD_DIM),
                             df_o.reshape(b, s_len, DIFF_HEADS * DIFF_V_DIM),
                             mem_o.reshape(b, s_len, MEM_HEADS * HEAD_DIM)], axis=-1)
    y = (mixed * jax.nn.silu(gate)) @ w_out
    return _layer_norm(DEEPNORM_ALPHA * x + y, ln_g, ln_b)


def _odd_layer(x, mem, positions, w_in, w_memkv, sinks, w_out, ln_g, ln_b):
    b, s_len = x.shape[0], x.shape[1]
    h = x @ w_in
    c_q, c_k, c_v, m_q, gate = _split(h, ODD_WIDTHS)
    c_q = _partial_rope(c_q.reshape(b, s_len, SWA_KV_HEADS, SWA_GROUP, HEAD_DIM), positions)
    c_k = _partial_rope(c_k.reshape(b, s_len, SWA_KV_HEADS, HEAD_DIM), positions)
    c_o = _sliding_window_attention(c_q, c_k, c_v.reshape(b, s_len, SWA_KV_HEADS, HEAD_DIM), sinks)
    mem_o = _memory_attention(m_q, mem, w_memkv)
    mixed = jnp.concatenate([c_o.reshape(b, s_len, SWA_Q_HEADS * HEAD_DIM),
                             mem_o.reshape(b, s_len, MEM_HEADS * HEAD_DIM)], axis=-1)
    y = (mixed * jax.nn.silu(gate)) @ w_out
    return _layer_norm(DEEPNORM_ALPHA * x + y, ln_g, ln_b)


def _col_scale(widths, value_slots):
    scale = np.ones((sum(widths),), np.float32)
    edges = [0]
    for w in widths:
        edges.append(edges[-1] + w)
    for s in value_slots:
        scale[edges[s]:edges[s + 1]] = DEEPNORM_BETA
    return jnp.asarray(scale)


def setup_inputs(seed: int = 0) -> dict:
    key = jax.random.key(seed)
    ks = jax.random.split(key, 16)

    def nrm(k, shape, std):
        return std * jax.random.normal(k, shape, jnp.float32)

    fan = D_MODEL ** -0.5
    x = nrm(ks[0], (BATCH, SEQ, D_MODEL), 1.0)
    mem = nrm(ks[1], (BATCH, MEM_LEN, D_MODEL), 1.0)
    offsets = jax.random.randint(ks[2], (BATCH, 1), 0, 4096, dtype=jnp.int32)
    positions = offsets + jnp.arange(SEQ, dtype=jnp.int32)[None, :]
    memkv_scale = jnp.concatenate([jnp.ones((MEM_HEADS * HEAD_DIM,), jnp.float32),
                                   jnp.full((MEM_HEADS * HEAD_DIM,), DEEPNORM_BETA, jnp.float32)])
    out_std = MIX_WIDTH ** -0.5 * DEEPNORM_BETA
    return {
        'x': x,
        'mem': mem,
        'positions': positions,
        'w_in_even': nrm(ks[3], (N_EVEN, D_MODEL, EVEN_IN), fan) * _col_scale(EVEN_WIDTHS, EVEN_VALUE_SLOTS),
        'w_memkv_even': nrm(ks[4], (N_EVEN, D_MODEL, 2 * MEM_HEADS * HEAD_DIM), fan) * memkv_scale,
        'diff_lambda_even': nrm(ks[5], (N_EVEN, 4, DIFF_QK_DIM), 0.1),
        'diff_subln_even': 1.0 + nrm(ks[6], (N_EVEN, DIFF_V_DIM), 0.02),
        'w_out_even': nrm(ks[7], (N_EVEN, MIX_WIDTH, D_MODEL), out_std),
        'ln_g_even': 1.0 + nrm(ks[8], (N_EVEN, D_MODEL), 0.02),
        'ln_b_even': nrm(ks[9], (N_EVEN, D_MODEL), 0.02),
        'w_in_odd': nrm(ks[10], (N_ODD, D_MODEL, ODD_IN), fan) * _col_scale(ODD_WIDTHS, ODD_VALUE_SLOTS),
        'w_memkv_odd': nrm(ks[11], (N_ODD, D_MODEL, 2 * MEM_HEADS * HEAD_DIM), fan) * memkv_scale,
        'sinks_odd': nrm(ks[12], (N_ODD, SWA_Q_HEADS), 0.5),
        'w_out_odd': nrm(ks[13], (N_ODD, MIX_WIDTH, D_MODEL), out_std),
        'ln_g_odd': 1.0 + nrm(ks[14], (N_ODD, D_MODEL), 0.02),
        'ln_b_odd': nrm(ks[15], (N_ODD, D_MODEL), 0.02),
    }


def reference(x, mem, positions, w_in_even, w_memkv_even, diff_lambda_even, diff_subln_even,
              w_out_even, ln_g_even, ln_b_even, w_in_odd, w_memkv_odd, sinks_odd, w_out_odd,
              ln_g_odd, ln_b_odd):
    for i in range(DEPTH):
        j = i // 2
        if i % 2 == 0:
            x = _even_layer(x, mem, positions, w_in_even[j], w_memkv_even[j], diff_lambda_even[j],
                            diff_subln_even[j], w_out_even[j], ln_g_even[j], ln_b_even[j], i)
        else:
            x = _odd_layer(x, mem, positions, w_in_odd[j], w_memkv_odd[j], sinks_odd[j],
                           w_out_odd[j], ln_g_odd[j], ln_b_odd[j])
    return x
```

```cpp
#include <hip/hip_runtime.h>
#include <hip/hip_cooperative_groups.h>
#include <stdint.h>
#include <cstdio>
namespace cg = cooperative_groups;

#define DI __device__ __forceinline__
typedef unsigned short bf16_t;
typedef short bf16x8 __attribute__((ext_vector_type(8)));
typedef float f32x4 __attribute__((ext_vector_type(4)));
typedef float f32x16 __attribute__((ext_vector_type(16)));
typedef unsigned u32x4 __attribute__((ext_vector_type(4)));
typedef unsigned u32x2 __attribute__((ext_vector_type(2)));

constexpr int NB = 2, SEQ = 8192, DM = 1024, NTOK = NB * SEQ;
constexpr int HWE = 3584, HWO = 2560;
constexpr float LOG2E = 1.4426950408889634f;
constexpr float QS64 = 0.125f * LOG2E;
constexpr float QS32 = 0.17677669529663687f * LOG2E;
constexpr float ALPHA = 1.4142135623730951f;
constexpr float LN_EPS = 1e-5f;
#define NEG_INF (-__builtin_inff())


#define VTID  ((int)(threadIdx.x & 255))
#define VGRP  ((int)(threadIdx.x >> 8))
#define VBLK  ((int)(blockIdx.x * 2 + (threadIdx.x >> 8)))
#define VGRID ((int)(gridDim.x * 2))

struct Params {
    const float* x; const float* mem; const int* pos;
    const float* w_in_e; const float* w_mkv_e; const float* dlam; const float* subln; const float* w_out_e; const float* lng_e; const float* lnb_e;
    const float* w_in_o; const float* w_mkv_o; const float* sinks; const float* w_out_o; const float* lng_o; const float* lnb_o;
    float* out;
    bf16_t* xb; bf16_t* H; bf16_t* VT; bf16_t* G;
    bf16_t* WinE; bf16_t* WoutE; bf16_t* WinO; bf16_t* WoutO; bf16_t* Wmkv;
    bf16_t* memb; bf16_t* MK; bf16_t* MVT; float* rope; unsigned long long* lnx; unsigned* ctr; unsigned* bar;
};

typedef __bf16 bf16x2_t __attribute__((ext_vector_type(2)));
typedef float f32x2 __attribute__((ext_vector_type(2)));
DI unsigned cvt_pk(float lo, float hi) { f32x2 v = {lo, hi}; bf16x2_t b = __builtin_convertvector(v, bf16x2_t); return __builtin_bit_cast(unsigned, b); }
DI float bflo(unsigned u) { return __uint_as_float(u << 16); }
DI float bfhi(unsigned u) { return __uint_as_float(u & 0xffff0000u); }
DI float ex2(float x) { return __builtin_amdgcn_exp2f(x); }
DI float lg2(float x) { return __builtin_amdgcn_logf(x); }
DI f32x4 mfma16(bf16x8 a, bf16x8 b, f32x4 c) { return __builtin_amdgcn_mfma_f32_16x16x32_bf16(a, b, c, 0, 0, 0); }
DI f32x16 mfma32(bf16x8 a, bf16x8 b, f32x16 c) { return __builtin_amdgcn_mfma_f32_32x32x16_bf16(a, b, c, 0, 0, 0); }
DI float xhalf(float v) {
    const auto rr = __builtin_amdgcn_permlane32_swap(__float_as_uint(v), __float_as_uint(v), false, false);
    return __uint_as_float((VTID & 32) ? rr[0] : rr[1]);
}

DI void sincos_acc(float ang, float& s, float& c) {
    const double a = (double)ang;
    const double kd = __builtin_rint(a * 0.63661977236758134308);
    const double r = __builtin_fma(-kd, 6.12323399573676603587e-17, __builtin_fma(-kd, 1.57079632679489655800, a));
    const double r2 = r * r;
    double sp = 1.6059043836821613e-10;
    sp = sp * r2 - 2.5052108385441720e-08;
    sp = sp * r2 + 2.7557319223985893e-06;
    sp = sp * r2 - 1.9841269841269841e-04;
    sp = sp * r2 + 8.3333333333333332e-03;
    sp = sp * r2 - 1.6666666666666666e-01;
    const double sr = r + r * r2 * sp;
    double cp = -1.1470745597729725e-11;
    cp = cp * r2 + 2.0876756987868100e-09;
    cp = cp * r2 - 2.7557319223985888e-07;
    cp = cp * r2 + 2.4801587301587302e-05;
    cp = cp * r2 - 1.3888888888888889e-03;
    cp = cp * r2 + 4.1666666666666664e-02;
    cp = cp * r2 - 0.5;
    const double cr = 1.0 + r2 * cp;
    const int q = ((int)kd) & 3;
    const double ss = (q & 1) ? cr : sr, cc = (q & 1) ? sr : cr;
    s = (float)((q & 2) ? -ss : ss);
    c = (float)(((q + 1) & 2) ? -cc : cc);
}

DI void conv8(const float* src, bf16_t* dst, long n8) {
    const long gt = (long)VBLK * 256 + VTID, nth = (long)VGRID * 256;
    long i = gt;
    for (; i + nth < n8; i += 2 * nth) {
        const f32x4 a0 = __builtin_nontemporal_load((const f32x4*)src + 2 * i), b0 = __builtin_nontemporal_load((const f32x4*)src + 2 * i + 1);
        const f32x4 a1 = __builtin_nontemporal_load((const f32x4*)src + 2 * (i + nth)), b1 = __builtin_nontemporal_load((const f32x4*)src + 2 * (i + nth) + 1);
        u32x4 w0, w1;
        w0.x = cvt_pk(a0.x, a0.y); w0.y = cvt_pk(a0.z, a0.w); w0.z = cvt_pk(b0.x, b0.y); w0.w = cvt_pk(b0.z, b0.w);
        w1.x = cvt_pk(a1.x, a1.y); w1.y = cvt_pk(a1.z, a1.w); w1.z = cvt_pk(b1.x, b1.y); w1.w = cvt_pk(b1.z, b1.w);
        ((u32x4*)dst)[i] = w0; ((u32x4*)dst)[i + nth] = w1;
    }
    for (; i < n8; i += nth) {
        const f32x4 a = __builtin_nontemporal_load((const f32x4*)src + 2 * i), b = __builtin_nontemporal_load((const f32x4*)src + 2 * i + 1);
        u32x4 w; w.x = cvt_pk(a.x, a.y); w.y = cvt_pk(a.z, a.w); w.z = cvt_pk(b.x, b.y); w.w = cvt_pk(b.z, b.w);
        ((u32x4*)dst)[i] = w;
    }
}

DI void phase_prep(const Params& p, char* lds) {
    const int tid = VTID;
    conv8(p.x, p.xb, (long)NTOK * DM / 8);
    conv8(p.mem, p.memb, 512L * 1024 / 8);
    {
        const long gt = (long)VBLK * 256 + tid, nth = (long)VGRID * 256;
        for (long i = gt; i < (long)NTOK * 8; i += nth) {
            const int tok = (int)(i >> 3), f = (int)(i & 7);
            const float invf = expf(-((float)f * 0.125f) * 13.122363377404328f);
            const float ang = (float)p.pos[tok] * invf;
            float s, c; sincos_acc(ang, s, c);
            p.rope[tok * 16 + f] = c; p.rope[tok * 16 + 8 + f] = s;
        }
    }
    {
        const long gt = (long)VBLK * 256 + tid, nth = (long)VGRID * 256;
        for (long i = gt; i < 128 * 128; i += nth) {
            const int row = (int)(i >> 7), rr = row < 64 ? 960 + row : 1216 + (row - 64);
            ((u32x4*)(p.WinO + (long)rr * 1024))[i & 127] = (u32x4){0u, 0u, 0u, 0u};
        }
    }
    float* tile = (float*)lds;
    for (int t = VBLK; t < 2272; t += VGRID) {
        const float* W; bf16_t* Wt; int N; int lt = t; int pm = 0;
        if (lt < 896) { W = p.w_in_e; Wt = p.WinE; N = 3584; pm = 1; }
        else if ((lt -= 896) < 256) { W = p.w_out_e; Wt = p.WoutE; N = 1024; }
        else if ((lt -= 256) < 608) { W = p.w_in_o; Wt = p.WinO; N = 2432; pm = 2; }
        else if ((lt -= 608) < 256) { W = p.w_out_o; Wt = p.WoutO; N = 1024; }
        else if ((lt -= 256) < 128) { W = p.w_mkv_e; Wt = p.Wmkv; N = 512; }
        else { lt -= 128; W = p.w_mkv_o; Wt = p.Wmkv + 512 * 1024; N = 512; }
        const int k0 = (lt & 15) * 64, n0 = (lt >> 4) * 64;
#pragma unroll
        for (int i = 0; i < 16; ++i) {
            const int idx = tid + 256 * i, kk = idx >> 6, nn = idx & 63;
            tile[kk * 65 + nn] = __builtin_nontemporal_load(W + (long)(k0 + kk) * N + n0 + nn);
        }
        __syncthreads();
        const int n = tid >> 2, kq = tid & 3;
        unsigned w[8];
#pragma unroll
        for (int j = 0; j < 8; ++j) w[j] = cvt_pk(tile[(kq * 16 + 2 * j) * 65 + n], tile[(kq * 16 + 2 * j + 1) * 65 + n]);
        int drow = n0 + n;
        if (pm == 1 && drow >= 1152 && drow < 1920) { const int dd = drow & 31; if (dd < 8) drow = (drow & ~7) + (dd < 4 ? 2 * dd : 2 * (dd - 4) + 1); }
        if (pm == 2 && drow < 960) { const int dd = drow & 63; if (dd < 16) drow = (drow & ~15) + (dd < 8 ? 2 * dd : 2 * (dd - 8) + 1); }
        else if (pm == 2) drow += (drow >= 1152) ? 128 : 64;
        u32x4* dst = (u32x4*)(Wt + (long)drow * 1024 + k0 + kq * 16);
        u32x4 w0 = {w[0], w[1], w[2], w[3]}, w1 = {w[4], w[5], w[6], w[7]};
        dst[0] = w0; dst[1] = w1;
        __syncthreads();
    }
}

DI void gemm_core256(const bf16_t* A, const bf16_t* Bt, int m0, int n0, bool vt, char* lds0, f32x4 (&acc)[4][8], int nj = 8) {
    const int tid = threadIdx.x, lane = tid & 63, wid = __builtin_amdgcn_readfirstlane(tid >> 6), wr = wid >> 2, wc = wid & 3, fr = lane & 15, fq = lane >> 4;
    const int sb = (tid & 63) * 16, swz = sb ^ (((sb >> 9) & 1) << 5);
    const int R0 = (tid >> 7) * 16 + (swz >> 6), C0 = ((tid >> 6) & 1) * 32 + ((swz & 63) >> 1);
    const bf16_t* ga = A + (long)(m0 + R0) * 1024 + C0;
    const bf16_t* gb = Bt + (long)(n0 + R0) * 1024 + C0;
    typedef __attribute__((address_space(3))) unsigned lds_u32;
    char* ldst = lds0 + tid * 16;
    int lane_ob = fr * 64 + fq * 16; lane_ob ^= ((lane_ob >> 9) & 1) << 5;
    const int xoff = (vt ? (((wc & 1) * 2 + wr) * 4) * 2048 : 32768 + (wc * 4) * 2048) + lane_ob;
    const int yoff = (vt ? 32768 + ((wc >> 1) * 8) * 2048 : (wr * nj) * 2048) + lane_ob;
#pragma unroll
    for (int i = 0; i < 4; ++i)
#pragma unroll
        for (int j = 0; j < 8; ++j) acc[i][j] = (f32x4){0.f, 0.f, 0.f, 0.f};
#define GLDS(KT, BUF) { _Pragma("unroll") for (int i = 0; i < 4; ++i) { unsigned o_ = (unsigned)(i * 131072 + (KT) * 128); asm volatile("" : "+s"(o_)); \
        if (2 * i < nj) __builtin_amdgcn_global_load_lds((const unsigned*)((const char*)ga + o_), (lds_u32*)(ldst + (BUF) * 65536 + i * 8192), 16, 0, 0); \
        __builtin_amdgcn_global_load_lds((const unsigned*)((const char*)gb + o_), (lds_u32*)(ldst + (BUF) * 65536 + 32768 + i * 8192), 16, 0, 0); } }
#define COMPUTE(BUF) { const char* base = lds0 + (BUF) * 65536; _Pragma("unroll") for (int kk = 0; kk < 2; ++kk) { bf16x8 X[4]; \
        _Pragma("unroll") for (int i = 0; i < 4; ++i) X[i] = *(const bf16x8*)(base + xoff + i * 2048 + kk * 1024); \
        _Pragma("unroll") for (int jh = 0; jh < 4; ++jh) if (2 * jh < nj) { bf16x8 Y[2]; \
            _Pragma("unroll") for (int j = 0; j < 2; ++j) Y[j] = *(const bf16x8*)(base + yoff + (jh * 2 + j) * 2048 + kk * 1024); \
            __builtin_amdgcn_s_setprio(1); \
            _Pragma("unroll") for (int i = 0; i < 4; ++i) _Pragma("unroll") for (int j = 0; j < 2; ++j) acc[i][jh * 2 + j] = mfma16(X[i], Y[j], acc[i][jh * 2 + j]); \
            __builtin_amdgcn_s_setprio(0); } } }
    GLDS(0, 0)
    __syncthreads();
#pragma unroll 1
    for (int kt = 0; kt < 16; kt += 2) {
        GLDS(kt + 1, 1)
        COMPUTE(0)
        __syncthreads();
        if (kt + 2 < 16) GLDS(kt + 2, 0)
        COMPUTE(1)
        __syncthreads();
    }
#undef GLDS
#undef COMPUTE
}

struct EpiDesc {
    int kind; float scale;
    bf16_t* dst; int ld; int dcol0;
    bf16_t* vt; int vrow0, vtr, vld, tshift;
};

DI void gemm_epi256(const Params& p, const EpiDesc& e, int m0, const f32x4 (&acc)[4][8], int nj = 8) {
    const int lane = threadIdx.x & 63, wid = __builtin_amdgcn_readfirstlane(threadIdx.x >> 6), wr = wid >> 2, wc = wid & 3, fr = lane & 15, fq = lane >> 4;
    if (e.kind == 4) {
        const int tokq = (wc & 1) * 2 + wr;
        const int tok0 = m0 + tokq * 64 + fq * 4, b = tok0 >> e.tshift, s0 = tok0 & ((1 << e.tshift) - 1);
        bf16_t* rowp = e.vt + ((long)(b * e.vtr + e.vrow0 + fr) * e.vld + s0);
#pragma unroll
        for (int j = 0; j < 8; ++j) {
#pragma unroll
            for (int i = 0; i < 4; ++i) {
                u32x2 w; w.x = cvt_pk(acc[i][j][0], acc[i][j][1]); w.y = cvt_pk(acc[i][j][2], acc[i][j][3]);
                *(u32x2*)(rowp + i * 16) = w;
            }
            rowp += (long)16 * e.vld;
        }
        return;
    }
    const int wc64 = wc & 1;
#pragma unroll
    for (int j = 0; j < 8; ++j) {
        if (j >= nj) break;
        const int tok = m0 + wr * (16 * nj) + j * 16 + fr;
        float ca = 1.f, sa = 0.f, cb = 1.f, sb = 0.f;
        if (e.kind == 1 && fq < 2) {
            const float* rp = p.rope + (long)tok * 16 + 4 * fq;
            ca = rp[0]; sa = rp[8]; cb = rp[2]; sb = rp[10];
        } else if (e.kind == 2) {
            const float* rp = p.rope + (long)tok * 16 + 2 * fq;
            ca = rp[0]; sa = rp[8]; cb = rp[1]; sb = rp[9];
        }
#pragma unroll
        for (int i = 0; i < 4; ++i) {
            f32x4 v = acc[i][j];
            if ((e.kind == 1 && (i & 1) == 0) || (e.kind == 2 && i == 0)) {
                const float x1a = v[0], x2a = v[1], x1b = v[2], x2b = v[3];
                v[0] = x1a * ca - x2a * sa; v[1] = x2a * ca + x1a * sa;
                v[2] = x1b * cb - x2b * sb; v[3] = x2b * cb + x1b * sb;
            }
            if (e.kind == 3) {
#pragma unroll
                for (int r = 0; r < 4; ++r) v[r] = v[r] * __builtin_amdgcn_rcpf(1.f + ex2(-LOG2E * v[r]));
            } else {
#pragma unroll
                for (int r = 0; r < 4; ++r) v[r] *= e.scale;
            }
            u32x2 w; w.x = cvt_pk(v[0], v[1]); w.y = cvt_pk(v[2], v[3]);
            *(u32x2*)(e.dst + (long)tok * e.ld + e.dcol0 + wc64 * 64 + i * 16 + fq * 4) = w;
        }
        __builtin_amdgcn_sched_barrier(0);
    }
}

template <int WHICH> DI void inproj_tile256(const Params& p, char* lds0, int L, int tm, int tn, int m0_ = -1, int nj = 8) {
    const int wc = __builtin_amdgcn_readfirstlane(threadIdx.x >> 6) & 3, tn128 = tn * 2 + (wc >> 1);
    f32x4 acc[4][8];
    EpiDesc e; e.kind = 0; e.scale = 1.f; e.dst = p.H; e.ld = HWE; e.dcol0 = tn128 * 128; e.vt = p.VT; e.vrow0 = 0; e.vtr = 768; e.vld = SEQ; e.tshift = 13;
    const bf16_t *A, *Bt;
    if (WHICH == 2) {
        A = p.memb; Bt = p.Wmkv + (long)L * 512 * 1024;
        if (tn128 < 2) { e.kind = 0; e.dst = p.MK + (long)L * 512 * 256; e.ld = 256; }
        else { e.kind = 4; e.vt = p.MVT + (long)L * 2 * 256 * 256; e.vrow0 = (tn128 - 2) * 128; e.vtr = 256; e.vld = 256; e.tshift = 8; }
    } else if (WHICH == 0) {
        A = p.xb; Bt = p.WinE;
        if (tn128 < 3) { e.kind = 0; e.scale = QS64; }
        else if (tn128 < 6) { e.kind = 0; }
        else if (tn128 < 9) { e.kind = 4; e.vrow0 = (tn128 - 6) * 128; }
        else if (tn128 < 12) { e.kind = 1; e.scale = QS32; }
        else if (tn128 < 15) { e.kind = 1; }
        else if (tn128 < 18) { e.kind = 4; e.vrow0 = 384 + (tn128 - 15) * 128; }
        else if (tn128 < 20) { e.kind = 0; e.scale = QS64; }
        else { e.kind = 3; }
    } else {
        A = p.xb; Bt = p.WinO; e.ld = HWO; e.vtr = 256;
        if (tn128 < 6) { e.kind = 2; e.scale = QS64; }
        else if (tn128 < 8) { e.kind = 2; }
        else if (tn128 < 10) { e.kind = 4; e.vrow0 = (tn128 - 8) * 128; }
        else if (tn128 < 12) { e.kind = 0; e.scale = QS64; }
        else { e.kind = 3; }
    }
    const int m0 = m0_ >= 0 ? m0_ : tm * 256;
    gemm_core256(A, Bt, m0, tn * 256, e.kind == 4, lds0, acc, nj);
    gemm_epi256(p, e, m0, acc, nj);
}

DI void gemm_phase_inproj_even(const Params& p, char* lds0) {
    const int nlb = gridDim.x >> 3, xcd = blockIdx.x / nlb, lb = blockIdx.x % nlb;
    for (int q = lb; q < 8 * 14; q += nlb) inproj_tile256<0>(p, lds0, 0, xcd * 8 + (q & 7), q >> 3);
    for (int t = (int)gridDim.x - 1 - (int)blockIdx.x; t < 8; t += gridDim.x) inproj_tile256<2>(p, lds0, t >> 2, (t >> 1) & 1, t & 1);
}
DI void gemm_phase_inproj_odd(const Params& p, char* lds0) {
    const int nlb = gridDim.x >> 3, xcd = blockIdx.x / nlb, lb = blockIdx.x % nlb;
    const bool halves = (nlb == 32);
    const int trips = halves ? 3 : (80 - lb + nlb - 1) / nlb;
    for (int r = 0; r < trips; ++r) {
        const bool half = halves && r == 2;
        const int q = half ? (lb >> 1) : lb + r * nlb;
        const int tn = half ? 8 + (q >> 3) : (q >> 3);
        const int m0 = (xcd * 8 + (q & 7)) * 256 + (half ? (lb & 1) * 128 : 0);
        inproj_tile256<1>(p, lds0, 0, 0, tn, m0, half ? 4 : 8);
    }
}

DI void gemm_phase_outproj_ln(const Params& p, const bf16_t* Wt, const float* xin, const float* g, const float* bta, bool write_xb, int layer, char* lds0) {
    const int lane = threadIdx.x & 63, wid = __builtin_amdgcn_readfirstlane(threadIdx.x >> 6), wr = wid >> 2, wc = wid & 3, fr = lane & 15, fq = lane >> 4;
    const int nlb = gridDim.x >> 3, xcd = blockIdx.x / nlb, lb = blockIdx.x % nlb;
    typedef float f32x2v __attribute__((ext_vector_type(2)));
    for (int q = lb; q < 8 * 4; q += nlb) {
        f32x4 acc[4][8];
        const int tm = xcd * 8 + (q & 7), tn = q >> 3;
        gemm_core256(p.G, Wt, tm * 256, tn * 256, false, lds0, acc);
        f32x2v* P = (f32x2v*)lds0;
        f32x2v* S2 = (f32x2v*)(lds0 + 8192);
#pragma unroll
        for (int j = 0; j < 8; ++j) {
            const long tok = tm * 256 + wr * 128 + j * 16 + fr;
            float sm = 0.f, sq = 0.f;
#pragma unroll
            for (int i = 0; i < 4; ++i) {
                const f32x4 xv = __builtin_nontemporal_load((const f32x4*)(xin + tok * 1024 + tn * 256 + wc * 64 + i * 16 + fq * 4));
#pragma unroll
                for (int r = 0; r < 4; ++r) { const float v = ALPHA * xv[r] + acc[i][j][r]; acc[i][j][r] = v; sm += v; sq += v * v; }
                if (i & 1) __builtin_amdgcn_sched_barrier(0);
            }
            sm += __shfl_xor(sm, 16); sm += __shfl_xor(sm, 32);
            sq += __shfl_xor(sq, 16); sq += __shfl_xor(sq, 32);
            if (fq == 0) P[(wr * 128 + j * 16 + fr) * 4 + wc] = (f32x2v){sm, sq};
            __builtin_amdgcn_sched_barrier(0);
        }
        __syncthreads();
        unsigned long long* xr = p.lnx + ((size_t)layer * NTOK + (size_t)tm * 256) * 4;
        unsigned* cnt = p.ctr + 64 + layer * 64 + tm;
        if (threadIdx.x < 256) {
            const f32x2v a = P[threadIdx.x * 4 + 0], b = P[threadIdx.x * 4 + 1], c = P[threadIdx.x * 4 + 2], d = P[threadIdx.x * 4 + 3];
            const f32x2v t = {(a.x + b.x) + (c.x + d.x), (a.y + b.y) + (c.y + d.y)};
            __hip_atomic_store(xr + threadIdx.x * 4 + tn, __builtin_bit_cast(unsigned long long, t), __ATOMIC_RELAXED, __HIP_MEMORY_SCOPE_AGENT);
        }
        asm volatile("s_waitcnt vmcnt(0)" ::: "memory");
        __syncthreads();
        if (threadIdx.x == 0) {
            __hip_atomic_fetch_add(cnt, 1u, __ATOMIC_RELAXED, __HIP_MEMORY_SCOPE_AGENT);
            unsigned sp = 0;
            while (__hip_atomic_load(cnt, __ATOMIC_RELAXED, __HIP_MEMORY_SCOPE_AGENT) < 4u && ++sp < (1u << 22)) __builtin_amdgcn_s_sleep(0);
        }
        __syncthreads();
        if (threadIdx.x < 256) {
            float S = 0.f, Q = 0.f;
#pragma unroll
            for (int k = 0; k < 4; ++k) {
                const f32x2v t = __builtin_bit_cast(f32x2v, __hip_atomic_load(xr + threadIdx.x * 4 + k, __ATOMIC_RELAXED, __HIP_MEMORY_SCOPE_AGENT));
                S += t.x; Q += t.y;
            }
            const float mu = S * (1.f / 1024.f);
            const float var = fmaxf(Q * (1.f / 1024.f) - mu * mu, 0.f);
            S2[threadIdx.x] = (f32x2v){mu, 1.0f / sqrtf(var + LN_EPS)};
        }
        __syncthreads();
#pragma unroll
        for (int j = 0; j < 8; ++j) {
            const int row = wr * 128 + j * 16 + fr;
            const long tok = tm * 256 + row;
            const f32x2v st = S2[row];
#pragma unroll
            for (int i = 0; i < 4; ++i) {
                const int col = tn * 256 + wc * 64 + i * 16 + fq * 4;
                const f32x4 gg = *(const f32x4*)(g + col), bb = *(const f32x4*)(bta + col);
                f32x4 y;
#pragma unroll
                for (int r = 0; r < 4; ++r) y[r] = (acc[i][j][r] - st.x) * st.y * gg[r] + bb[r];
                *(f32x4*)(p.out + tok * 1024 + col) = y;
                if (write_xb) { u32x2 w; w.x = cvt_pk(y[0], y[1]); w.y = cvt_pk(y[2], y[3]); *(u32x2*)(p.xb + tok * 1024 + col) = w; }
                __builtin_amdgcn_sched_barrier(0);
            }
        }
        __syncthreads();
    }
}

DI bf16x8 pack8(const f32x16& s, int h8) {
    u32x4 w;
    if (h8 == 0) { w.x = cvt_pk(s[0], s[1]); w.y = cvt_pk(s[2], s[3]); w.z = cvt_pk(s[4], s[5]); w.w = cvt_pk(s[6], s[7]); }
    else { w.x = cvt_pk(s[8], s[9]); w.y = cvt_pk(s[10], s[11]); w.z = cvt_pk(s[12], s[13]); w.w = cvt_pk(s[14], s[15]); }
    return __builtin_bit_cast(bf16x8, w);
}

DI float sm_init(float m) { return (m == NEG_INF) ? 0.f : -m; }
DI float max3f(float a, float b, float c) { return fmaxf(fmaxf(a, b), c); }
DI void softmax_step(f32x16& s0, f32x16& s1, float& m, float& l, f32x16& o0, f32x16& o1) {
    float a = max3f(s0[0], s0[1], s1[0]), b = max3f(s0[2], s0[3], s1[1]);
    a = max3f(a, s1[2], s1[3]);
#pragma unroll
    for (int r = 4; r < 16; r += 4) { a = max3f(a, s0[r], s0[r + 1]); b = max3f(b, s0[r + 2], s0[r + 3]); a = max3f(a, s1[r], s1[r + 1]); b = max3f(b, s1[r + 2], s1[r + 3]); }
    float mx = fmaxf(a, b);
    mx = fmaxf(mx, xhalf(mx));
    const bool uninit = (m == NEG_INF);
    const bool need = uninit ? (mx > NEG_INF) : (mx > 8.f);
    if (__any(need)) {
        const float shift = need ? mx : 0.f;
        const float alpha = (need && !uninit) ? ex2(-mx) : 1.f;
        m = need ? ((uninit ? 0.f : m) + mx) : m;
#pragma unroll
        for (int i = 0; i < 16; ++i) { s0[i] -= shift; s1[i] -= shift; o0[i] *= alpha; o1[i] *= alpha; }
        l *= alpha;
    }
    float rs = 0.f;
#pragma unroll
    for (int i = 0; i < 16; ++i) { s0[i] = ex2(s0[i]); s1[i] = ex2(s1[i]); rs += s0[i] + s1[i]; }
    l += rs;
}

template <int MODE>
DI void attn_item(const Params& p, char* lds, int b, int head, int qb, int layer, float lam) {
    const int tid = threadIdx.x, lane = tid & 63, wid = tid >> 6, r32 = lane & 31, hi = lane >> 5;
    const int t0 = (MODE == 2) ? qb * 64 : qb * 256;
    const int wrow_min = (MODE == 2) ? t0 + (wid & 1) * 32 : t0 + wid * 32, wrow_max = wrow_min + 31;
    const int trow = wrow_min + r32;
    if (MODE == 2) head = head * 4 + (wid >> 1);
    int* misc = (int*)(lds + 32768);

    const bf16_t *qp, *kp, *vp, *gp; long kst, vst; int hw, outcol;
    if (MODE == 0) {
        hw = HWE; qp = p.H + (long)b * SEQ * HWE + head * 64; kp = p.H + (long)b * SEQ * HWE + 384 + head * 64; kst = HWE;
        vp = p.VT + (long)(b * 768 + head * 64) * SEQ; vst = SEQ; outcol = head * 64; gp = p.H + (long)b * SEQ * HWE + 2560 + outcol;
    } else if (MODE == 1) {
        hw = HWE; qp = p.H + (long)b * SEQ * HWE + 1152 + head * 64; kp = p.H + (long)b * SEQ * HWE + 1536 + head * 64; kst = HWE;
        vp = p.VT + (long)(b * 768 + 384 + head * 64) * SEQ; vst = SEQ; outcol = 384 + head * 64; gp = p.H + (long)b * SEQ * HWE + 2560 + outcol;
    } else if (MODE == 2) {
        const int kv = head >> 2;
        hw = HWO; qp = p.H + (long)b * SEQ * HWO + head * 64; kp = p.H + (long)b * SEQ * HWO + 768 + kv * 64; kst = HWO;
        vp = p.VT + (long)(b * 256 + kv * 64) * SEQ; vst = SEQ; outcol = head * 64; gp = p.H + (long)b * SEQ * HWO + 1536 + outcol;
    } else {
        outcol = 768 + head * 64;
        if (layer == 0) { hw = HWE; qp = p.H + (long)b * SEQ * HWE + 2304 + head * 64; gp = p.H + (long)b * SEQ * HWE + 2560 + outcol; }
        else { hw = HWO; qp = p.H + (long)b * SEQ * HWO + 1280 + head * 64; gp = p.H + (long)b * SEQ * HWO + 1536 + outcol; }
        kp = p.MK + (long)layer * 512 * 256 + (long)b * 256 * 256 + head * 64; kst = 256;
        vp = p.MVT + (long)layer * 2 * 256 * 256 + (long)(b * 256 + head * 64) * 256; vst = 256;
    }
    bf16_t* op = p.G + (long)b * SEQ * 1024 + outcol;

    bf16x8 qf[4];
    {
        const bf16_t* q = qp + (long)trow * hw + hi * 8;
#pragma unroll
        for (int d0 = 0; d0 < 4; ++d0) qf[d0] = *(const bf16x8*)(q + d0 * 16);
    }
    int kt_lo, kt_hi;
    if (MODE == 0 || MODE == 1) { kt_lo = 0; kt_hi = (t0 >> 6) + 3; }
    else if (MODE == 2) { kt_hi = (t0 >> 6); kt_lo = (t0 >> 6) - 2; if (kt_lo < 0) kt_lo = 0; }
    else { kt_lo = 0; kt_hi = 3; }
    const int nt = kt_hi - kt_lo + 1;
    constexpr bool REV = (MODE == 0);

    const int srow = tid >> 3, sch = tid & 7;
    const int so = srow * 128 + ((sch ^ ((srow >> 1) & 7)) << 4);
    const bf16_t* kg = kp + (long)srow * kst + sch * 8;
    const bf16_t* vg = vp + (long)srow * vst + sch * 8;
    const int pr = (r32 & 0x13) | ((r32 & 4) << 1) | ((r32 & 8) >> 1);
    const int kx = (pr >> 1) & 7, vx = (r32 >> 1) & 7;
    int koff[4], voff[4];
#pragma unroll
    for (int d0 = 0; d0 < 4; ++d0) { koff[d0] = pr * 128 + (((2 * d0 + hi) ^ kx) << 4); voff[d0] = 16384 + r32 * 128 + (((2 * d0 + hi) ^ vx) << 4); }

    f32x16 O[2][2];
#pragma unroll
    for (int c = 0; c < 2; ++c)
#pragma unroll
        for (int h = 0; h < 2; ++h)
#pragma unroll
            for (int i = 0; i < 16; ++i) O[c][h][i] = 0.f;
    float m[2] = {NEG_INF, NEG_INF}, l[2] = {0.f, 0.f};
    float carry = 0.f;

    u32x4 rk0, rv0;
    {
        const int key0 = (REV ? kt_hi : kt_lo) * 64;
        rk0 = *(const u32x4*)(kg + (long)key0 * kst);
        rv0 = *(const u32x4*)(vg + key0);
        *(u32x4*)(lds + so) = rk0;
        *(u32x4*)(lds + 16384 + so) = rv0;
    }
    __syncthreads();
#pragma unroll 1
    for (int it = 0; it < nt; ++it) {
        const int key0 = (REV ? kt_hi - it : kt_lo + it) * 64;
        if (it + 1 < nt) {
            const int key1 = (REV ? kt_hi - it - 1 : kt_lo + it + 1) * 64;
            rk0 = *(const u32x4*)(kg + (long)key1 * kst);
            rv0 = *(const u32x4*)(vg + key1);
        }
        const char* kb_ = lds + (it & 1) * 8192;
        const char* vb_ = lds + (it & 1) * 8192;
        bool skip = false, need_mask = false;
        if (MODE == 0) { skip = key0 > wrow_max; need_mask = key0 + 63 >= wrow_min; }
        if (MODE == 1) { skip = key0 > wrow_max; need_mask = key0 + 63 > wrow_min; }
        if (MODE == 2) { skip = (key0 > wrow_max) || (key0 + 63 <= wrow_min - 128); need_mask = (key0 + 63 > wrow_min) || (key0 <= wrow_max - 128); }
        const int rel = trow - key0 - 8 * hi;
        if (!skip) {
            if (MODE == 2 || MODE == 3) {
                f32x16 s0, s1;
                const float c0 = sm_init(m[0]);
#pragma unroll
                for (int i = 0; i < 16; ++i) { s0[i] = c0; s1[i] = c0; }
#pragma unroll
                for (int d0 = 0; d0 < 4; ++d0) {
                    const bf16x8 k0 = *(const bf16x8*)(kb_ + koff[d0]), k1 = *(const bf16x8*)(kb_ + 4096 + koff[d0]);
                    s0 = mfma32(k0, qf[d0], s0); s1 = mfma32(k1, qf[d0], s1);
                }
                if (MODE == 2 && need_mask) {
#pragma unroll
                    for (int i = 0; i < 16; ++i) {
                        const int e0 = 16 * (i >> 3) + (i & 7), e1 = e0 + 32;
                        if (!(e0 <= rel && e0 > rel - 128)) s0[i] = NEG_INF;
                        if (!(e1 <= rel && e1 > rel - 128)) s1[i] = NEG_INF;
                    }
                }
                softmax_step(s0, s1, m[0], l[0], O[0][0], O[0][1]);
#pragma unroll
                for (int c2 = 0; c2 < 4; ++c2) {
                    const bf16x8 pf = pack8(c2 < 2 ? s0 : s1, c2 & 1);
                    const bf16x8 v0 = *(const bf16x8*)(vb_ + voff[c2]), v1 = *(const bf16x8*)(vb_ + voff[c2] + 4096);
                    O[0][0] = mfma32(v0, pf, O[0][0]); O[0][1] = mfma32(v1, pf, O[0][1]);
                }
            } else if (MODE == 1) {
                bf16x8 pa[4];
                {
                    f32x16 s0, s1;
                    const float c0 = sm_init(m[0]);
#pragma unroll
                    for (int i = 0; i < 16; ++i) { s0[i] = c0; s1[i] = c0; }
#pragma unroll
                    for (int d0 = 0; d0 < 2; ++d0) {
                        const bf16x8 k0 = *(const bf16x8*)(kb_ + koff[d0]), k1 = *(const bf16x8*)(kb_ + 4096 + koff[d0]);
                        s0 = mfma32(k0, qf[d0], s0); s1 = mfma32(k1, qf[d0], s1);
                    }
                    if (need_mask) {
#pragma unroll
                        for (int i = 0; i < 16; ++i) {
                            const int e0 = 16 * (i >> 3) + (i & 7), e1 = e0 + 32;
                            if (!(e0 <= rel)) s0[i] = NEG_INF;
                            if (!(e1 <= rel)) s1[i] = NEG_INF;
                        }
                    }
                    softmax_step(s0, s1, m[0], l[0], O[0][0], O[0][1]);
#pragma unroll
                    for (int c2 = 0; c2 < 4; ++c2) pa[c2] = pack8(c2 < 2 ? s0 : s1, c2 & 1);
                }
                __builtin_amdgcn_sched_barrier(0);
                f32x16 b0, b1;
                {
                    const float c1 = sm_init(m[1]);
#pragma unroll
                    for (int i = 0; i < 16; ++i) { b0[i] = c1; b1[i] = c1; }
                }
#pragma unroll
                for (int d0 = 2; d0 < 4; ++d0) {
                    const bf16x8 k0 = *(const bf16x8*)(kb_ + koff[d0]), k1 = *(const bf16x8*)(kb_ + 4096 + koff[d0]);
                    b0 = mfma32(k0, qf[d0], b0); b1 = mfma32(k1, qf[d0], b1);
                }
#pragma unroll
                for (int c2 = 0; c2 < 4; ++c2) {
                    const bf16x8 v0 = *(const bf16x8*)(vb_ + voff[c2]), v1 = *(const bf16x8*)(vb_ + voff[c2] + 4096);
                    O[0][0] = mfma32(v0, pa[c2], O[0][0]); O[0][1] = mfma32(v1, pa[c2], O[0][1]);
                }
                __builtin_amdgcn_sched_barrier(0);
                if (need_mask) {
#pragma unroll
                    for (int i = 0; i < 16; ++i) {
                        const int e0 = 16 * (i >> 3) + (i & 7), e1 = e0 + 32;
                        if (!(e0 <= rel)) b0[i] = NEG_INF;
                        if (!(e1 <= rel)) b1[i] = NEG_INF;
                    }
                }
                softmax_step(b0, b1, m[1], l[1], O[1][0], O[1][1]);
#pragma unroll
                for (int c2 = 0; c2 < 4; ++c2) {
                    const bf16x8 pf = pack8(c2 < 2 ? b0 : b1, c2 & 1);
                    const bf16x8 v0 = *(const bf16x8*)(vb_ + voff[c2]), v1 = *(const bf16x8*)(vb_ + voff[c2] + 4096);
                    O[1][0] = mfma32(v0, pf, O[1][0]); O[1][1] = mfma32(v1, pf, O[1][1]);
                }
            } else {
                f32x16 s[2];
#pragma unroll
                for (int i = 0; i < 16; ++i) { s[0][i] = 0.f; s[1][i] = 0.f; }
#pragma unroll
                for (int d0 = 0; d0 < 4; ++d0) {
                    const bf16x8 k0 = *(const bf16x8*)(kb_ + koff[d0]), k1 = *(const bf16x8*)(kb_ + 4096 + koff[d0]);
                    s[0] = mfma32(k0, qf[d0], s[0]); s[1] = mfma32(k1, qf[d0], s[1]);
                }
                float T[4];
#pragma unroll
                for (int g = 0; g < 4; ++g) {
                    float run = 0.f;
#pragma unroll
                    for (int e = 7; e >= 0; --e) {
                        const int idx = (g & 1) * 8 + e;
                        const float z = s[g >> 1][idx];
                        const float sp = fmaxf(z, 0.f) + lg2(1.f + ex2(-fabsf(z)));
                        const bool valid = !need_mask || (16 * g + e < rel);
                        const float L = valid ? -sp : 0.f;
                        s[g >> 1][idx] = valid ? (z + L + run) : NEG_INF;
                        run += L;
                    }
                    T[g] = run;
                }
                float Hs[4]; float accs = 0.f;
#pragma unroll
                for (int g = 3; g >= 0; --g) {
                    const float To = xhalf(T[g]);
                    Hs[g] = accs + (hi == 0 ? To : 0.f);
                    accs += T[g] + To;
                }
#pragma unroll
                for (int g = 0; g < 4; ++g) {
                    const float off = Hs[g] + carry;
#pragma unroll
                    for (int e = 0; e < 8; ++e) { const int idx = (g & 1) * 8 + e; s[g >> 1][idx] = ex2(s[g >> 1][idx] + off); }
                }
                carry += accs;
#pragma unroll
                for (int c2 = 0; c2 < 4; ++c2) {
                    const bf16x8 pf = pack8(c2 < 2 ? s[0] : s[1], c2 & 1);
                    const bf16x8 v0 = *(const bf16x8*)(vb_ + voff[c2]), v1 = *(const bf16x8*)(vb_ + voff[c2] + 4096);
                    O[0][0] = mfma32(v0, pf, O[0][0]); O[0][1] = mfma32(v1, pf, O[0][1]);
                }
            }
        }
        if (MODE == 0) {
            const bool wdone = __all(carry < -160.f);
            if (lane == 0) misc[4 + (it & 1) * 8 + wid] = wdone ? 1 : 0;
        }
        if (it + 1 < nt) {
            char* nb = lds + ((it + 1) & 1) * 8192;
            *(u32x4*)(nb + so) = rk0;
            *(u32x4*)(nb + 16384 + so) = rv0;
        }
        __syncthreads();
        if (MODE == 0) {
            const int* f = misc + 4 + (it & 1) * 8;
            if (f[0] & f[1] & f[2] & f[3] & f[4] & f[5] & f[6] & f[7]) break;
        }
    }

    if (MODE == 3) {
        const float inv = 1.f / (l[0] + xhalf(l[0]));
#pragma unroll
        for (int i = 0; i < 16; ++i) { O[0][0][i] *= inv; O[0][1][i] *= inv; }
    } else if (MODE == 2) {
        const float lt = l[0] + xhalf(l[0]);
        const float sk = p.sinks[head] * LOG2E;
        const float mf = fmaxf(m[0], sk);
        const float a = ex2(m[0] - mf);
        const float f = a / (lt * a + ex2(sk - mf));
#pragma unroll
        for (int i = 0; i < 16; ++i) { O[0][0][i] *= f; O[0][1][i] *= f; }
    } else if (MODE == 1) {
        const float i1 = 1.f / (l[0] + xhalf(l[0])), i2 = lam / (l[1] + xhalf(l[1]));
        float ss = 0.f;
#pragma unroll
        for (int i = 0; i < 16; ++i) {
            O[0][0][i] = O[0][0][i] * i1 - O[1][0][i] * i2; O[0][1][i] = O[0][1][i] * i1 - O[1][1][i] * i2;
            ss += O[0][0][i] * O[0][0][i] + O[0][1][i] * O[0][1][i];
        }
        ss += xhalf(ss);
        const float rn = 0.8f / sqrtf(ss * (1.f / 64.f) + LN_EPS);
#pragma unroll
        for (int dh = 0; dh < 2; ++dh)
#pragma unroll
            for (int g = 0; g < 4; ++g) {
                const f32x4 sg = *(const f32x4*)(p.subln + dh * 32 + g * 8 + hi * 4);
#pragma unroll
                for (int r = 0; r < 4; ++r) O[0][dh][4 * g + r] *= rn * sg[r];
            }
    }
#pragma unroll
    for (int dh = 0; dh < 2; ++dh)
#pragma unroll
        for (int g = 0; g < 4; ++g) {
            const int d = dh * 32 + g * 8 + hi * 4;
            const u32x2 gg = *(const u32x2*)(gp + (long)trow * hw + d);
            u32x2 w;
            w.x = cvt_pk(O[0][dh][4 * g + 0] * bflo(gg.x), O[0][dh][4 * g + 1] * bfhi(gg.x));
            w.y = cvt_pk(O[0][dh][4 * g + 2] * bflo(gg.y), O[0][dh][4 * g + 3] * bfhi(gg.y));
            *(u32x2*)(op + (long)trow * 1024 + d) = w;
        }
}

DI void attn_phase_even(const Params& p, char* lds) {
    float lam;
    {
        float a = 0.f, c = 0.f;
        for (int i = 0; i < 32; ++i) { a += p.dlam[i] * p.dlam[32 + i]; c += p.dlam[64 + i] * p.dlam[96 + i]; }
        lam = expf(a) - expf(c) + 0.2f;
    }
    int* misc = (int*)(lds + 32768);
    for (;;) {
        __syncthreads();
        if (threadIdx.x == 0) misc[0] = (int)atomicAdd(p.ctr + 0, 1u);
        __syncthreads();
        const int item = misc[0];
        if (item >= 1024) break;
        if (item < 384) { const int qb = 31 - item / 12, bh = item % 12; attn_item<1>(p, lds, bh / 6, bh % 6, qb, 0, lam); }
        else if (item < 768) { const int u = item - 384; const int qb = 31 - u / 12, bh = u % 12; attn_item<0>(p, lds, bh / 6, bh % 6, qb, 0, lam); }
        else { const int u = item - 768; const int qb = u >> 3, bh = u & 7; attn_item<3>(p, lds, bh >> 2, bh & 3, qb, 0, lam); }
    }
}

DI void attn_phase_odd(const Params& p, char* lds) {
    int* misc = (int*)(lds + 32768);
    for (;;) {
        __syncthreads();
        if (threadIdx.x == 0) misc[0] = (int)atomicAdd(p.ctr + 1, 1u);
        __syncthreads();
        const int item = misc[0];
        if (item >= 1024) break;
        if (item < 768) { const int qb = item / 6, r = item % 6; attn_item<2>(p, lds, r / 3, r % 3, qb, 1, 0.f); }
        else { const int u = item - 768; const int qb = u >> 3, bh = u & 7; attn_item<3>(p, lds, bh >> 2, bh & 3, qb, 1, 0.f); }
    }
}

#define XB_TMO      128
#define XB_XCNT(j)  (256  + 64 * (j))
#define XB_XSUB(j)  (1280 + 64 * (j))
#define XB_XGEN(j)  (2304 + 64 * (j))
#define XB_TOP      3328
#define XB_TOPGEN   3392
#define XCD_BAR_WORDS 3456
#define XB_SPIN_CAP (1u << 18)
DI unsigned xb_ld(unsigned* p)              { return __hip_atomic_load(p, __ATOMIC_RELAXED, __HIP_MEMORY_SCOPE_AGENT); }
DI unsigned xb_add(unsigned* p, unsigned v) { return __hip_atomic_fetch_add(p, v, __ATOMIC_RELAXED, __HIP_MEMORY_SCOPE_AGENT); }
DI unsigned xb_xcc_id() { return (unsigned)__builtin_amdgcn_s_getreg((3 << 11) | 20) & 0xFu; }
#define XB_SPIN(cond, bar) do { unsigned _sp = 0; while (cond) { __builtin_amdgcn_s_sleep(0); \
    if ((++_sp & 255u) == 0u) { if (xb_ld(&(bar)[XB_TMO])) break; if (_sp > XB_SPIN_CAP) { atomicAdd(&(bar)[XB_TMO], 1u); break; } } } } while (0)
struct XcdBarrier { unsigned* bar; unsigned x; };
DI XcdBarrier xcd_barrier_post(unsigned* bar) {
    XcdBarrier b; b.bar = bar; b.x = xb_xcc_id();
    if (threadIdx.x == 0) (void)xb_add(&bar[XB_XCNT(b.x)], 1u);
    return b;
}
DI void xcd_barrier_complete(unsigned* bar, unsigned x, unsigned& nloc, unsigned& nx) {
    const unsigned G = gridDim.x * gridDim.y * gridDim.z;
    unsigned sum, cnt, mine, sp = 0u;
    for (;;) {
        sum = 0u; cnt = 0u; mine = 0u;
#pragma unroll
        for (unsigned j = 0; j < 16; ++j) { const unsigned c = xb_ld(&bar[XB_XCNT(j)]); sum += c; cnt += (c > 0u) ? 1u : 0u; mine = (j == x) ? c : mine; }
        if (sum == G) break;
        __builtin_amdgcn_s_sleep(1);
        if ((++sp & 255u) == 0u) { if (xb_ld(&bar[XB_TMO])) break; if (sp > XB_SPIN_CAP) { atomicAdd(&bar[XB_TMO], 1u); break; } }
    }
    nloc = mine > 0u ? mine : 1u; nx = cnt > 0u ? cnt : 1u;
}
DI void xcd_barrier(const XcdBarrier& b) {
    asm volatile("s_waitcnt vmcnt(0)" ::: "memory");
    __syncthreads();
    if (threadIdx.x == 0) {
        unsigned* bar = b.bar;
        __builtin_amdgcn_s_waitcnt(0);
        unsigned nloc, nx;
        xcd_barrier_complete(bar, b.x, nloc, nx);
        const unsigned old = xb_add(&bar[XB_XSUB(b.x)], 1u);
        const unsigned gen = old / nloc;
        if (old + 1u == (gen + 1u) * nloc) {
            __builtin_amdgcn_fence(__ATOMIC_RELEASE, "agent");
            asm volatile("s_waitcnt vmcnt(0)" ::: "memory");
            const unsigned og = xb_add(&bar[XB_TOP], 1u);
            const unsigned tg = og / nx;
            if (og + 1u == (tg + 1u) * nx) xb_add(&bar[XB_TOPGEN], 1u);
            else XB_SPIN(xb_ld(&bar[XB_TOPGEN]) == tg, bar);
            __builtin_amdgcn_fence(__ATOMIC_ACQUIRE, "agent");
            xb_add(&bar[XB_XGEN(b.x)], 1u);
            asm volatile("s_waitcnt vmcnt(0)" ::: "memory");
        } else {
            XB_SPIN(xb_ld(&bar[XB_XGEN(b.x)]) == gen, bar);
            __builtin_amdgcn_fence(__ATOMIC_ACQUIRE, "agent");
            asm volatile("s_waitcnt vmcnt(0)" ::: "memory");
        }
    }
    __syncthreads();
}

template <bool COOP>
__global__ void __launch_bounds__(512, 2) mega(Params p, int ph_lo, int ph_hi) {
    extern __shared__ __attribute__((aligned(16))) char lds_dyn[];
    char* lds = lds_dyn + (threadIdx.x >> 8) * 65536;
    const XcdBarrier xb = xcd_barrier_post(p.bar);
    if (COOP && ph_hi == 0x7fffffff) cg::this_grid().sync();
#define PHASE(k, body) if (ph_lo <= (k) && (k) < ph_hi) { if (COOP && (k) > ph_lo) xcd_barrier(xb); body; }
    PHASE(0, phase_prep(p, lds))
    PHASE(1, gemm_phase_inproj_even(p, lds_dyn))
    PHASE(2, attn_phase_even(p, lds_dyn))
    PHASE(3, gemm_phase_outproj_ln(p, p.WoutE, p.x, p.lng_e, p.lnb_e, true, 0, lds_dyn))
    PHASE(5, gemm_phase_inproj_odd(p, lds_dyn))
    PHASE(6, attn_phase_odd(p, lds_dyn))
    PHASE(7, gemm_phase_outproj_ln(p, p.WoutO, p.out, p.lng_o, p.lnb_o, false, 1, lds_dyn))
#undef PHASE
}

extern "C" void kernel_launch(void* const* d_in, const int* in_sizes, int n_in, void* d_out, int out_size, void* d_ws, size_t ws_size, hipStream_t stream) {
    Params p{};
    p.x = (const float*)d_in[0]; p.mem = (const float*)d_in[1]; p.pos = (const int*)d_in[2];
    p.w_in_e = (const float*)d_in[3]; p.w_mkv_e = (const float*)d_in[4]; p.dlam = (const float*)d_in[5]; p.subln = (const float*)d_in[6];
    p.w_out_e = (const float*)d_in[7]; p.lng_e = (const float*)d_in[8]; p.lnb_e = (const float*)d_in[9];
    p.w_in_o = (const float*)d_in[10]; p.w_mkv_o = (const float*)d_in[11]; p.sinks = (const float*)d_in[12]; p.w_out_o = (const float*)d_in[13];
    p.lng_o = (const float*)d_in[14]; p.lnb_o = (const float*)d_in[15];
    p.out = (float*)d_out;
    char* w = (char*)d_ws; size_t o = 0;
    auto take = [&](size_t bytes) { char* r = w + o; o += (bytes + 255) & ~(size_t)255; return r; };
    p.xb = (bf16_t*)take((size_t)NTOK * DM * 2);
    p.H = (bf16_t*)take((size_t)NTOK * HWE * 2);
    p.VT = (bf16_t*)take((size_t)NB * 768 * SEQ * 2);
    p.G = (bf16_t*)take((size_t)NTOK * DM * 2);
    p.WinE = (bf16_t*)take((size_t)HWE * 1024 * 2);
    p.WoutE = (bf16_t*)take((size_t)1024 * 1024 * 2);
    p.WinO = (bf16_t*)take((size_t)HWO * 1024 * 2);
    p.WoutO = (bf16_t*)take((size_t)1024 * 1024 * 2);
    p.Wmkv = (bf16_t*)take((size_t)2 * 512 * 1024 * 2);
    p.memb = (bf16_t*)take((size_t)512 * 1024 * 2);
    p.MK = (bf16_t*)take((size_t)2 * 512 * 256 * 2);
    p.MVT = (bf16_t*)take((size_t)2 * 2 * 256 * 256 * 2);
    p.rope = (float*)take((size_t)NTOK * 16 * 4);
    p.lnx = (unsigned long long*)take((size_t)2 * NTOK * 4 * 8);
    p.ctr = (unsigned*)take(1024);
    p.bar = (unsigned*)take(XCD_BAR_WORDS * 4);

    static int grid = 0;
    if (!grid) {
        int dev = 0, cus = 0, per = 0;
        hipGetDevice(&dev);
        hipDeviceGetAttribute(&cus, hipDeviceAttributeMultiprocessorCount, dev);
        hipFuncSetAttribute((const void*)mega<true>, hipFuncAttributeMaxDynamicSharedMemorySize, 131072);
        hipOccupancyMaxActiveBlocksPerMultiprocessor(&per, mega<true>, 512, 131072);
        if (per > 1) per = 1;
        if (per < 1) per = 1;
        grid = cus * per;
        if (grid != 256) fprintf(stderr, "this kernel expects a 256-workgroup cooperative grid (got %d): the fused LayerNorm exchange needs one out-projection tile per workgroup\n", grid);
    }
    hipMemsetAsync(p.ctr, 0, 1024 + XCD_BAR_WORDS * 4, stream);
    int lo = 0, hi = 9;
    void* args[] = {&p, &lo, &hi};
    hipError_t e = hipLaunchCooperativeKernel((void*)mega<true>, dim3(grid), dim3(512), args, 131072, stream);
    if (e != hipSuccess) fprintf(stderr, "cooperative launch failed: %s (grid %d)\n", hipGetErrorString(e), grid);
}
```

```cpp
#include <hip/hip_runtime.h>
#include <hip/hip_cooperative_groups.h>
#include <stdint.h>
#include <cstdio>
namespace cg = cooperative_groups;

#define DI __device__ __forceinline__
typedef unsigned short bf16_t;
typedef short bf16x8 __attribute__((ext_vector_type(8)));
typedef float f32x4 __attribute__((ext_vector_type(4)));
typedef float f32x16 __attribute__((ext_vector_type(16)));
typedef unsigned u32x4 __attribute__((ext_vector_type(4)));
typedef unsigned u32x2 __attribute__((ext_vector_type(2)));

constexpr int NB = 2, SEQ = 8192, DM = 1024, NTOK = NB * SEQ;
constexpr int HWE = 3584, HWO = 2560;
constexpr float LOG2E = 1.4426950408889634f;
constexpr float QS64 = 0.125f * LOG2E;
constexpr float QS32 = 0.17677669529663687f * LOG2E;
constexpr float ALPHA = 1.4142135623730951f;
constexpr float LN_EPS = 1e-5f;
#define NEG_INF (-__builtin_inff())


#define VTID  ((int)(threadIdx.x & 255))
#define VGRP  ((int)(threadIdx.x >> 8))
#define VBLK  ((int)(blockIdx.x * 2 + (threadIdx.x >> 8)))
#define VGRID ((int)(gridDim.x * 2))

struct Params {
    const float* x; const float* mem; const int* pos;
    const float* w_in_e; const float* w_mkv_e; const float* dlam; const float* subln; const float* w_out_e; const float* lng_e; const float* lnb_e;
    const float* w_in_o; const float* w_mkv_o; const float* sinks; const float* w_out_o; const float* lng_o; const float* lnb_o;
    float* out;
    bf16_t* xb; bf16_t* H; bf16_t* VT; bf16_t* G;
    bf16_t* WinE; bf16_t* WoutE; bf16_t* WinO; bf16_t* WoutO; bf16_t* Wmkv;
    bf16_t* memb; bf16_t* MK; bf16_t* MVT; float* rope; unsigned long long* lnx; unsigned* ctr; unsigned* bar;
};

typedef __bf16 bf16x2_t __attribute__((ext_vector_type(2)));
typedef float f32x2 __attribute__((ext_vector_type(2)));
DI unsigned cvt_pk(float lo, float hi) { f32x2 v = {lo, hi}; bf16x2_t b = __builtin_convertvector(v, bf16x2_t); return __builtin_bit_cast(unsigned, b); }
DI float bflo(unsigned u) { return __uint_as_float(u << 16); }
DI float bfhi(unsigned u) { return __uint_as_float(u & 0xffff0000u); }
DI float ex2(float x) { return __builtin_amdgcn_exp2f(x); }
DI float lg2(float x) { return __builtin_amdgcn_logf(x); }
DI f32x4 mfma16(bf16x8 a, bf16x8 b, f32x4 c) { return __builtin_amdgcn_mfma_f32_16x16x32_bf16(a, b, c, 0, 0, 0); }
DI f32x16 mfma32(bf16x8 a, bf16x8 b, f32x16 c) { return __builtin_amdgcn_mfma_f32_32x32x16_bf16(a, b, c, 0, 0, 0); }
DI float xhalf(float v) {
    const auto rr = __builtin_amdgcn_permlane32_swap(__float_as_uint(v), __float_as_uint(v), false, false);
    return __uint_as_float((VTID & 32) ? rr[0] : rr[1]);
}

DI void sincos_acc(float ang, float& s, float& c) {
    const double a = (double)ang;
    const double kd = __builtin_rint(a * 0.63661977236758134308);
    const double r = __builtin_fma(-kd, 6.12323399573676603587e-17, __builtin_fma(-kd, 1.57079632679489655800, a));
    const double r2 = r * r;
    double sp = 1.6059043836821613e-10;
    sp = sp * r2 - 2.5052108385441720e-08;
    sp = sp * r2 + 2.7557319223985893e-06;
    sp = sp * r2 - 1.9841269841269841e-04;
    sp = sp * r2 + 8.3333333333333332e-03;
    sp = sp * r2 - 1.6666666666666666e-01;
    const double sr = r + r * r2 * sp;
    double cp = -1.1470745597729725e-11;
    cp = cp * r2 + 2.0876756987868100e-09;
    cp = cp * r2 - 2.7557319223985888e-07;
    cp = cp * r2 + 2.4801587301587302e-05;
    cp = cp * r2 - 1.3888888888888889e-03;
    cp = cp * r2 + 4.1666666666666664e-02;
    cp = cp * r2 - 0.5;
    const double cr = 1.0 + r2 * cp;
    const int q = ((int)kd) & 3;
    const double ss = (q & 1) ? cr : sr, cc = (q & 1) ? sr : cr;
    s = (float)((q & 2) ? -ss : ss);
    c = (float)(((q + 1) & 2) ? -cc : cc);
}

DI void conv8(const float* src, bf16_t* dst, long n8) {
    const long gt = (long)VBLK * 256 + VTID, nth = (long)VGRID * 256;
    long i = gt;
    for (; i + nth < n8; i += 2 * nth) {
        const f32x4 a0 = __builtin_nontemporal_load((const f32x4*)src + 2 * i), b0 = __builtin_nontemporal_load((const f32x4*)src + 2 * i + 1);
        const f32x4 a1 = __builtin_nontemporal_load((const f32x4*)src + 2 * (i + nth)), b1 = __builtin_nontemporal_load((const f32x4*)src + 2 * (i + nth) + 1);
        u32x4 w0, w1;
        w0.x = cvt_pk(a0.x, a0.y); w0.y = cvt_pk(a0.z, a0.w); w0.z = cvt_pk(b0.x, b0.y); w0.w = cvt_pk(b0.z, b0.w);
        w1.x = cvt_pk(a1.x, a1.y); w1.y = cvt_pk(a1.z, a1.w); w1.z = cvt_pk(b1.x, b1.y); w1.w = cvt_pk(b1.z, b1.w);
        ((u32x4*)dst)[i] = w0; ((u32x4*)dst)[i + nth] = w1;
    }
    for (; i < n8; i += nth) {
        const f32x4 a = __builtin_nontemporal_load((const f32x4*)src + 2 * i), b = __builtin_nontemporal_load((const f32x4*)src + 2 * i + 1);
        u32x4 w; w.x = cvt_pk(a.x, a.y); w.y = cvt_pk(a.z, a.w); w.z = cvt_pk(b.x, b.y); w.w = cvt_pk(b.z, b.w);
        ((u32x4*)dst)[i] = w;
    }
}

DI void phase_prep(const Params& p, char* lds) {
    const int tid = VTID;
    conv8(p.x, p.xb, (long)NTOK * DM / 8);
    conv8(p.mem, p.memb, 512L * 1024 / 8);
    {
        const long gt = (long)VBLK * 256 + tid, nth = (long)VGRID * 256;
        for (long i = gt; i < (long)NTOK * 8; i += nth) {
            const int tok = (int)(i >> 3), f = (int)(i & 7);
            const float invf = expf(-((float)f * 0.125f) * 13.122363377404328f);
            const float ang = (float)p.pos[tok] * invf;
            float s, c; sincos_acc(ang, s, c);
            p.rope[tok * 16 + f] = c; p.rope[tok * 16 + 8 + f] = s;
        }
    }
    {
        const long gt = (long)VBLK * 256 + tid, nth = (long)VGRID * 256;
        for (long i = gt; i < 128 * 128; i += nth) {
            const int row = (int)(i >> 7), rr = row < 64 ? 960 + row : 1216 + (row - 64);
            ((u32x4*)(p.WinO + (long)rr * 1024))[i & 127] = (u32x4){0u, 0u, 0u, 0u};
        }
    }
    float* tile = (float*)lds;
    for (int t = VBLK; t < 2272; t += VGRID) {
        const float* W; bf16_t* Wt; int N; int lt = t; int pm = 0;
        if (lt < 896) { W = p.w_in_e; Wt = p.WinE; N = 3584; pm = 1; }
        else if ((lt -= 896) < 256) { W = p.w_out_e; Wt = p.WoutE; N = 1024; }
        else if ((lt -= 256) < 608) { W = p.w_in_o; Wt = p.WinO; N = 2432; pm = 2; }
        else if ((lt -= 608) < 256) { W = p.w_out_o; Wt = p.WoutO; N = 1024; }
        else if ((lt -= 256) < 128) { W = p.w_mkv_e; Wt = p.Wmkv; N = 512; }
        else { lt -= 128; W = p.w_mkv_o; Wt = p.Wmkv + 512 * 1024; N = 512; }
        const int k0 = (lt & 15) * 64, n0 = (lt >> 4) * 64;
#pragma unroll
        for (int i = 0; i < 16; ++i) {
            const int idx = tid + 256 * i, kk = idx >> 6, nn = idx & 63;
            tile[kk * 65 + nn] = __builtin_nontemporal_load(W + (long)(k0 + kk) * N + n0 + nn);
        }
        __syncthreads();
        const int n = tid >> 2, kq = tid & 3;
        unsigned w[8];
#pragma unroll
        for (int j = 0; j < 8; ++j) w[j] = cvt_pk(tile[(kq * 16 + 2 * j) * 65 + n], tile[(kq * 16 + 2 * j + 1) * 65 + n]);
        int drow = n0 + n;
        if (pm == 1 && drow >= 1152 && drow < 1920) { const int dd = drow & 31; if (dd < 8) drow = (drow & ~7) + (dd < 4 ? 2 * dd : 2 * (dd - 4) + 1); }
        if (pm == 2 && drow < 960) { const int dd = drow & 63; if (dd < 16) drow = (drow & ~15) + (dd < 8 ? 2 * dd : 2 * (dd - 8) + 1); }
        else if (pm == 2) drow += (drow >= 1152) ? 128 : 64;
        u32x4* dst = (u32x4*)(Wt + (long)drow * 1024 + k0 + kq * 16);
        u32x4 w0 = {w[0], w[1], w[2], w[3]}, w1 = {w[4], w[5], w[6], w[7]};
        dst[0] = w0; dst[1] = w1;
        __syncthreads();
    }
}

DI void gemm_core256(const bf16_t* A, const bf16_t* Bt, int m0, int n0, bool vt, char* lds0, f32x4 (&acc)[4][8], int nj = 8) {
    const int tid = threadIdx.x, lane = tid & 63, wid = __builtin_amdgcn_readfirstlane(tid >> 6), wr = wid >> 2, wc = wid & 3, fr = lane & 15, fq = lane >> 4;
    const int sb = (tid & 63) * 16, swz = sb ^ (((sb >> 9) & 1) << 5);
    const int R0 = (tid >> 7) * 16 + (swz >> 6), C0 = ((tid >> 6) & 1) * 32 + ((swz & 63) >> 1);
    const bf16_t* ga = A + (long)(m0 + R0) * 1024 + C0;
    const bf16_t* gb = Bt + (long)(n0 + R0) * 1024 + C0;
    typedef __attribute__((address_space(3))) unsigned lds_u32;
    char* ldst = lds0 + tid * 16;
    int lane_ob = fr * 64 + fq * 16; lane_ob ^= ((lane_ob >> 9) & 1) << 5;
    const int xoff = (vt ? (((wc & 1) * 2 + wr) * 4) * 2048 : 32768 + (wc * 4) * 2048) + lane_ob;
    const int yoff = (vt ? 32768 + ((wc >> 1) * 8) * 2048 : (wr * nj) * 2048) + lane_ob;
#pragma unroll
    for (int i = 0; i < 4; ++i)
#pragma unroll
        for (int j = 0; j < 8; ++j) acc[i][j] = (f32x4){0.f, 0.f, 0.f, 0.f};
#define GLDS(KT, BUF) { _Pragma("unroll") for (int i = 0; i < 4; ++i) { unsigned o_ = (unsigned)(i * 131072 + (KT) * 128); asm volatile("" : "+s"(o_)); \
        if (2 * i < nj) __builtin_amdgcn_global_load_lds((const unsigned*)((const char*)ga + o_), (lds_u32*)(ldst + (BUF) * 65536 + i * 8192), 16, 0, 0); \
        __builtin_amdgcn_global_load_lds((const unsigned*)((const char*)gb + o_), (lds_u32*)(ldst + (BUF) * 65536 + 32768 + i * 8192), 16, 0, 0); } }
#define COMPUTE(BUF) { const char* base = lds0 + (BUF) * 65536; _Pragma("unroll") for (int kk = 0; kk < 2; ++kk) { bf16x8 X[4]; \
        _Pragma("unroll") for (int i = 0; i < 4; ++i) X[i] = *(const bf16x8*)(base + xoff + i * 2048 + kk * 1024); \
        _Pragma("unroll") for (int jh = 0; jh < 4; ++jh) if (2 * jh < nj) { bf16x8 Y[2]; \
            _Pragma("unroll") for (int j = 0; j < 2; ++j) Y[j] = *(const bf16x8*)(base + yoff + (jh * 2 + j) * 2048 + kk * 1024); \
            __builtin_amdgcn_s_setprio(1); \
            _Pragma("unroll") for (int i = 0; i < 4; ++i) _Pragma("unroll") for (int j = 0; j < 2; ++j) acc[i][jh * 2 + j] = mfma16(X[i], Y[j], acc[i][jh * 2 + j]); \
            __builtin_amdgcn_s_setprio(0); } } }
    GLDS(0, 0)
    __syncthreads();
#pragma unroll 1
    for (int kt = 0; kt < 16; kt += 2) {
        GLDS(kt + 1, 1)
        COMPUTE(0)
        __syncthreads();
        if (kt + 2 < 16) GLDS(kt + 2, 0)
        COMPUTE(1)
        __syncthreads();
    }
#undef GLDS
#undef COMPUTE
}

struct EpiDesc {
    int kind; float scale;
    bf16_t* dst; int ld; int dcol0;
    bf16_t* vt; int vrow0, vtr, vld, tshift;
};

DI void gemm_epi256(const Params& p, const EpiDesc& e, int m0, const f32x4 (&acc)[4][8], int nj = 8) {
    const int lane = threadIdx.x & 63, wid = __builtin_amdgcn_readfirstlane(threadIdx.x >> 6), wr = wid >> 2, wc = wid & 3, fr = lane & 15, fq = lane >> 4;
    if (e.kind == 4) {
        const int tokq = (wc & 1) * 2 + wr;
        const int tok0 = m0 + tokq * 64 + fq * 4, b = tok0 >> e.tshift, s0 = tok0 & ((1 << e.tshift) - 1);
        bf16_t* rowp = e.vt + ((long)(b * e.vtr + e.vrow0 + fr) * e.vld + s0);
#pragma unroll
        for (int j = 0; j < 8; ++j) {
#pragma unroll
            for (int i = 0; i < 4; ++i) {
                u32x2 w; w.x = cvt_pk(acc[i][j][0], acc[i][j][1]); w.y = cvt_pk(acc[i][j][2], acc[i][j][3]);
                *(u32x2*)(rowp + i * 16) = w;
            }
            rowp += (long)16 * e.vld;
        }
        return;
    }
    const int wc64 = wc & 1;
#pragma unroll
    for (int j = 0; j < 8; ++j) {
        if (j >= nj) break;
        const int tok = m0 + wr * (16 * nj) + j * 16 + fr;
        float ca = 1.f, sa = 0.f, cb = 1.f, sb = 0.f;
        if (e.kind == 1 && fq < 2) {
            const float* rp = p.rope + (long)tok * 16 + 4 * fq;
            ca = rp[0]; sa = rp[8]; cb = rp[2]; sb = rp[10];
        } else if (e.kind == 2) {
            const float* rp = p.rope + (long)tok * 16 + 2 * fq;
            ca = rp[0]; sa = rp[8]; cb = rp[1]; sb = rp[9];
        }
#pragma unroll
        for (int i = 0; i < 4; ++i) {
            f32x4 v = acc[i][j];
            if ((e.kind == 1 && (i & 1) == 0) || (e.kind == 2 && i == 0)) {
                const float x1a = v[0], x2a = v[1], x1b = v[2], x2b = v[3];
                v[0] = x1a * ca - x2a * sa; v[1] = x2a * ca + x1a * sa;
                v[2] = x1b * cb - x2b * sb; v[3] = x2b * cb + x1b * sb;
            }
            if (e.kind == 3) {
#pragma unroll
                for (int r = 0; r < 4; ++r) v[r] = v[r] * __builtin_amdgcn_rcpf(1.f + ex2(-LOG2E * v[r]));
            } else {
#pragma unroll
                for (int r = 0; r < 4; ++r) v[r] *= e.scale;
            }
            u32x2 w; w.x = cvt_pk(v[0], v[1]); w.y = cvt_pk(v[2], v[3]);
            *(u32x2*)(e.dst + (long)tok * e.ld + e.dcol0 + wc64 * 64 + i * 16 + fq * 4) = w;
        }
        __builtin_amdgcn_sched_barrier(0);
    }
}

template <int WHICH> DI void inproj_tile256(const Params& p, char* lds0, int L, int tm, int tn, int m0_ = -1, int nj = 8) {
    const int wc = __builtin_amdgcn_readfirstlane(threadIdx.x >> 6) & 3, tn128 = tn * 2 + (wc >> 1);
    f32x4 acc[4][8];
    EpiDesc e; e.kind = 0; e.scale = 1.f; e.dst = p.H; e.ld = HWE; e.dcol0 = tn128 * 128; e.vt = p.VT; e.vrow0 = 0; e.vtr = 768; e.vld = SEQ; e.tshift = 13;
    const bf16_t *A, *Bt;
    if (WHICH == 2) {
        A = p.memb; Bt = p.Wmkv + (long)L * 512 * 1024;
        if (tn128 < 2) { e.kind = 0; e.dst = p.MK + (long)L * 512 * 256; e.ld = 256; }
        else { e.kind = 4; e.vt = p.MVT + (long)L * 2 * 256 * 256; e.vrow0 = (tn128 - 2) * 128; e.vtr = 256; e.vld = 256; e.tshift = 8; }
    } else if (WHICH == 0) {
        A = p.xb; Bt = p.WinE;
        if (tn128 < 3) { e.kind = 0; e.scale = QS64; }
        else if (tn128 < 6) { e.kind = 0; }
        else if (tn128 < 9) { e.kind = 4; e.vrow0 = (tn128 - 6) * 128; }
        else if (tn128 < 12) { e.kind = 1; e.scale = QS32; }
        else if (tn128 < 15) { e.kind = 1; }
        else if (tn128 < 18) { e.kind = 4; e.vrow0 = 384 + (tn128 - 15) * 128; }
        else if (tn128 < 20) { e.kind = 0; e.scale = QS64; }
        else { e.kind = 3; }
    } else {
        A = p.xb; Bt = p.WinO; e.ld = HWO; e.vtr = 256;
        if (tn128 < 6) { e.kind = 2; e.scale = QS64; }
        else if (tn128 < 8) { e.kind = 2; }
        else if (tn128 < 10) { e.kind = 4; e.vrow0 = (tn128 - 8) * 128; }
        else if (tn128 < 12) { e.kind = 0; e.scale = QS64; }
        else { e.kind = 3; }
    }
    const int m0 = m0_ >= 0 ? m0_ : tm * 256;
    gemm_core256(A, Bt, m0, tn * 256, e.kind == 4, lds0, acc, nj);
    gemm_epi256(p, e, m0, acc, nj);
}

DI void gemm_phase_inproj_even(const Params& p, char* lds0) {
    const int nlb = gridDim.x >> 3, xcd = blockIdx.x / nlb, lb = blockIdx.x % nlb;
    for (int q = lb; q < 8 * 14; q += nlb) inproj_tile256<0>(p, lds0, 0, xcd * 8 + (q & 7), q >> 3);
    for (int t = (int)gridDim.x - 1 - (int)blockIdx.x; t < 8; t += gridDim.x) inproj_tile256<2>(p, lds0, t >> 2, (t >> 1) & 1, t & 1);
}
DI void gemm_phase_inproj_odd(const Params& p, char* lds0) {
    const int nlb = gridDim.x >> 3, xcd = blockIdx.x / nlb, lb = blockIdx.x % nlb;
    const bool halves = (nlb == 32);
    const int trips = halves ? 3 : (80 - lb + nlb - 1) / nlb;
    for (int r = 0; r < trips; ++r) {
        const bool half = halves && r == 2;
        const int q = half ? (lb >> 1) : lb + r * nlb;
        const int tn = half ? 8 + (q >> 3) : (q >> 3);
        const int m0 = (xcd * 8 + (q & 7)) * 256 + (half ? (lb & 1) * 128 : 0);
        inproj_tile256<1>(p, lds0, 0, 0, tn, m0, half ? 4 : 8);
    }
}

DI void gemm_phase_outproj_ln(const Params& p, const bf16_t* Wt, const float* xin, const float* g, const float* bta, bool write_xb, int layer, char* lds0) {
    const int lane = threadIdx.x & 63, wid = __builtin_amdgcn_readfirstlane(threadIdx.x >> 6), wr = wid >> 2, wc = wid & 3, fr = lane & 15, fq = lane >> 4;
    const int nlb = gridDim.x >> 3, xcd = blockIdx.x / nlb, lb = blockIdx.x % nlb;
    typedef float f32x2v __attribute__((ext_vector_type(2)));
    for (int q = lb; q < 8 * 4; q += nlb) {
        f32x4 acc[4][8];
        const int tm = xcd * 8 + (q & 7), tn = q >> 3;
        gemm_core256(p.G, Wt, tm * 256, tn * 256, false, lds0, acc);
        f32x2v* P = (f32x2v*)lds0;
        f32x2v* S2 = (f32x2v*)(lds0 + 8192);
#pragma unroll
        for (int j = 0; j < 8; ++j) {
            const long tok = tm * 256 + wr * 128 + j * 16 + fr;
            float sm = 0.f, sq = 0.f;
#pragma unroll
            for (int i = 0; i < 4; ++i) {
                const f32x4 xv = __builtin_nontemporal_load((const f32x4*)(xin + tok * 1024 + tn * 256 + wc * 64 + i * 16 + fq * 4));
#pragma unroll
                for (int r = 0; r < 4; ++r) { const float v = ALPHA * xv[r] + acc[i][j][r]; acc[i][j][r] = v; sm += v; sq += v * v; }
                if (i & 1) __builtin_amdgcn_sched_barrier(0);
            }
            sm += __shfl_xor(sm, 16); sm += __shfl_xor(sm, 32);
            sq += __shfl_xor(sq, 16); sq += __shfl_xor(sq, 32);
            if (fq == 0) P[(wr * 128 + j * 16 + fr) * 4 + wc] = (f32x2v){sm, sq};
            __builtin_amdgcn_sched_barrier(0);
        }
        __syncthreads();
        unsigned long long* xr = p.lnx + ((size_t)layer * NTOK + (size_t)tm * 256) * 4;
        unsigned* cnt = p.ctr + 64 + layer * 64 + tm;
        if (threadIdx.x < 256) {
            const f32x2v a = P[threadIdx.x * 4 + 0], b = P[threadIdx.x * 4 + 1], c = P[threadIdx.x * 4 + 2], d = P[threadIdx.x * 4 + 3];
            const f32x2v t = {(a.x + b.x) + (c.x + d.x), (a.y + b.y) + (c.y + d.y)};
            __hip_atomic_store(xr + threadIdx.x * 4 + tn, __builtin_bit_cast(unsigned long long, t), __ATOMIC_RELAXED, __HIP_MEMORY_SCOPE_AGENT);
        }
        asm volatile("s_waitcnt vmcnt(0)" ::: "memory");
        __syncthreads();
        if (threadIdx.x == 0) {
            __hip_atomic_fetch_add(cnt, 1u, __ATOMIC_RELAXED, __HIP_MEMORY_SCOPE_AGENT);
            unsigned sp = 0;
            while (__hip_atomic_load(cnt, __ATOMIC_RELAXED, __HIP_MEMORY_SCOPE_AGENT) < 4u && ++sp < (1u << 22)) __builtin_amdgcn_s_sleep(1);
        }
        __syncthreads();
        if (threadIdx.x < 256) {
            float S = 0.f, Q = 0.f;
#pragma unroll
            for (int k = 0; k < 4; ++k) {
                const f32x2v t = __builtin_bit_cast(f32x2v, __hip_atomic_load(xr + threadIdx.x * 4 + k, __ATOMIC_RELAXED, __HIP_MEMORY_SCOPE_AGENT));
                S += t.x; Q += t.y;
            }
            const float mu = S * (1.f / 1024.f);
            const float var = fmaxf(Q * (1.f / 1024.f) - mu * mu, 0.f);
            S2[threadIdx.x] = (f32x2v){mu, 1.0f / sqrtf(var + LN_EPS)};
        }
        __syncthreads();
#pragma unroll
        for (int j = 0; j < 8; ++j) {
            const int row = wr * 128 + j * 16 + fr;
            const long tok = tm * 256 + row;
            const f32x2v st = S2[row];
#pragma unroll
            for (int i = 0; i < 4; ++i) {
                const int col = tn * 256 + wc * 64 + i * 16 + fq * 4;
                const f32x4 gg = *(const f32x4*)(g + col), bb = *(const f32x4*)(bta + col);
                f32x4 y;
#pragma unroll
                for (int r = 0; r < 4; ++r) y[r] = (acc[i][j][r] - st.x) * st.y * gg[r] + bb[r];
                *(f32x4*)(p.out + tok * 1024 + col) = y;
                if (write_xb) { u32x2 w; w.x = cvt_pk(y[0], y[1]); w.y = cvt_pk(y[2], y[3]); *(u32x2*)(p.xb + tok * 1024 + col) = w; }
                __builtin_amdgcn_sched_barrier(0);
            }
        }
        __syncthreads();
    }
}

DI bf16x8 pack8(const f32x16& s, int h8) {
    u32x4 w;
    if (h8 == 0) { w.x = cvt_pk(s[0], s[1]); w.y = cvt_pk(s[2], s[3]); w.z = cvt_pk(s[4], s[5]); w.w = cvt_pk(s[6], s[7]); }
    else { w.x = cvt_pk(s[8], s[9]); w.y = cvt_pk(s[10], s[11]); w.z = cvt_pk(s[12], s[13]); w.w = cvt_pk(s[14], s[15]); }
    return __builtin_bit_cast(bf16x8, w);
}

DI float sm_init(float m) { return (m == NEG_INF) ? 0.f : -m; }
DI float max3f(float a, float b, float c) { return fmaxf(fmaxf(a, b), c); }
DI void softmax_step(f32x16& s0, f32x16& s1, float& m, float& l, f32x16& o0, f32x16& o1) {
    float a = max3f(s0[0], s0[1], s1[0]), b = max3f(s0[2], s0[3], s1[1]);
    a = max3f(a, s1[2], s1[3]);
#pragma unroll
    for (int r = 4; r < 16; r += 4) { a = max3f(a, s0[r], s0[r + 1]); b = max3f(b, s0[r + 2], s0[r + 3]); a = max3f(a, s1[r], s1[r + 1]); b = max3f(b, s1[r + 2], s1[r + 3]); }
    float mx = fmaxf(a, b);
    mx = fmaxf(mx, xhalf(mx));
    const bool uninit = (m == NEG_INF);
    const bool need = uninit ? (mx > NEG_INF) : (mx > 8.f);
    if (__any(need)) {
        const float shift = need ? mx : 0.f;
        const float alpha = (need && !uninit) ? ex2(-mx) : 1.f;
        m = need ? ((uninit ? 0.f : m) + mx) : m;
#pragma unroll
        for (int i = 0; i < 16; ++i) { s0[i] -= shift; s1[i] -= shift; o0[i] *= alpha; o1[i] *= alpha; }
        l *= alpha;
    }
    float rs = 0.f;
#pragma unroll
    for (int i = 0; i < 16; ++i) { s0[i] = ex2(s0[i]); s1[i] = ex2(s1[i]); rs += s0[i] + s1[i]; }
    l += rs;
}

template <int MODE>
DI void attn_item(const Params& p, char* lds, int b, int head, int qb, int layer, float lam) {
    const int tid = threadIdx.x, lane = tid & 63, wid = tid >> 6, r32 = lane & 31, hi = lane >> 5;
    const int t0 = (MODE == 2) ? qb * 64 : qb * 256;
    const int wrow_min = (MODE == 2) ? t0 + (wid & 1) * 32 : t0 + wid * 32, wrow_max = wrow_min + 31;
    const int trow = wrow_min + r32;
    if (MODE == 2) head = head * 4 + (wid >> 1);
    int* misc = (int*)(lds + 32768);

    const bf16_t *qp, *kp, *vp, *gp; long kst, vst; int hw, outcol;
    if (MODE == 0) {
        hw = HWE; qp = p.H + (long)b * SEQ * HWE + head * 64; kp = p.H + (long)b * SEQ * HWE + 384 + head * 64; kst = HWE;
        vp = p.VT + (long)(b * 768 + head * 64) * SEQ; vst = SEQ; outcol = head * 64; gp = p.H + (long)b * SEQ * HWE + 2560 + outcol;
    } else if (MODE == 1) {
        hw = HWE; qp = p.H + (long)b * SEQ * HWE + 1152 + head * 64; kp = p.H + (long)b * SEQ * HWE + 1536 + head * 64; kst = HWE;
        vp = p.VT + (long)(b * 768 + 384 + head * 64) * SEQ; vst = SEQ; outcol = 384 + head * 64; gp = p.H + (long)b * SEQ * HWE + 2560 + outcol;
    } else if (MODE == 2) {
        const int kv = head >> 2;
        hw = HWO; qp = p.H + (long)b * SEQ * HWO + head * 64; kp = p.H + (long)b * SEQ * HWO + 768 + kv * 64; kst = HWO;
        vp = p.VT + (long)(b * 256 + kv * 64) * SEQ; vst = SEQ; outcol = head * 64; gp = p.H + (long)b * SEQ * HWO + 1536 + outcol;
    } else {
        outcol = 768 + head * 64;
        if (layer == 0) { hw = HWE; qp = p.H + (long)b * SEQ * HWE + 2304 + head * 64; gp = p.H + (long)b * SEQ * HWE + 2560 + outcol; }
        else { hw = HWO; qp = p.H + (long)b * SEQ * HWO + 1280 + head * 64; gp = p.H + (long)b * SEQ * HWO + 1536 + outcol; }
        kp = p.MK + (long)layer * 512 * 256 + (long)b * 256 * 256 + head * 64; kst = 256;
        vp = p.MVT + (long)layer * 2 * 256 * 256 + (long)(b * 256 + head * 64) * 256; vst = 256;
    }
    bf16_t* op = p.G + (long)b * SEQ * 1024 + outcol;

    bf16x8 qf[4];
    {
        const bf16_t* q = qp + (long)trow * hw + hi * 8;
#pragma unroll
        for (int d0 = 0; d0 < 4; ++d0) qf[d0] = *(const bf16x8*)(q + d0 * 16);
    }
    int kt_lo, kt_hi;
    if (MODE == 0 || MODE == 1) { kt_lo = 0; kt_hi = (t0 >> 6) + 3; }
    else if (MODE == 2) { kt_hi = (t0 >> 6); kt_lo = (t0 >> 6) - 2; if (kt_lo < 0) kt_lo = 0; }
    else { kt_lo = 0; kt_hi = 3; }
    const int nt = kt_hi - kt_lo + 1;
    constexpr bool REV = (MODE == 0);

    const int srow = tid >> 3, sch = tid & 7;
    const int so = srow * 128 + ((sch ^ ((srow >> 1) & 7)) << 4);
    const bf16_t* kg = kp + (long)srow * kst + sch * 8;
    const bf16_t* vg = vp + (long)srow * vst + sch * 8;
    const int pr = (r32 & 0x13) | ((r32 & 4) << 1) | ((r32 & 8) >> 1);
    const int kx = (pr >> 1) & 7, vx = (r32 >> 1) & 7;
    int koff[4], voff[4];
#pragma unroll
    for (int d0 = 0; d0 < 4; ++d0) { koff[d0] = pr * 128 + (((2 * d0 + hi) ^ kx) << 4); voff[d0] = 16384 + r32 * 128 + (((2 * d0 + hi) ^ vx) << 4); }

    f32x16 O[2][2];
#pragma unroll
    for (int c = 0; c < 2; ++c)
#pragma unroll
        for (int h = 0; h < 2; ++h)
#pragma unroll
            for (int i = 0; i < 16; ++i) O[c][h][i] = 0.f;
    float m[2] = {NEG_INF, NEG_INF}, l[2] = {0.f, 0.f};
    float carry = 0.f;

    u32x4 rk0, rv0;
    {
        const int key0 = (REV ? kt_hi : kt_lo) * 64;
        rk0 = *(const u32x4*)(kg + (long)key0 * kst);
        rv0 = *(const u32x4*)(vg + key0);
        *(u32x4*)(lds + so) = rk0;
        *(u32x4*)(lds + 16384 + so) = rv0;
    }
    __syncthreads();
#pragma unroll 1
    for (int it = 0; it < nt; ++it) {
        const int key0 = (REV ? kt_hi - it : kt_lo + it) * 64;
        if (it + 1 < nt) {
            const int key1 = (REV ? kt_hi - it - 1 : kt_lo + it + 1) * 64;
            rk0 = *(const u32x4*)(kg + (long)key1 * kst);
            rv0 = *(const u32x4*)(vg + key1);
        }
        const char* kb_ = lds + (it & 1) * 8192;
        const char* vb_ = lds + (it & 1) * 8192;
        bool skip = false, need_mask = false;
        if (MODE == 0) { skip = key0 > wrow_max; need_mask = key0 + 63 >= wrow_min; }
        if (MODE == 1) { skip = key0 > wrow_max; need_mask = key0 + 63 > wrow_min; }
        if (MODE == 2) { skip = (key0 > wrow_max) || (key0 + 63 <= wrow_min - 128); need_mask = (key0 + 63 > wrow_min) || (key0 <= wrow_max - 128); }
        const int rel = trow - key0 - 8 * hi;
        if (!skip) {
            if (MODE == 2 || MODE == 3) {
                f32x16 s0, s1;
                const float c0 = sm_init(m[0]);
#pragma unroll
                for (int i = 0; i < 16; ++i) { s0[i] = c0; s1[i] = c0; }
#pragma unroll
                for (int d0 = 0; d0 < 4; ++d0) {
                    const bf16x8 k0 = *(const bf16x8*)(kb_ + koff[d0]), k1 = *(const bf16x8*)(kb_ + 4096 + koff[d0]);
                    s0 = mfma32(k0, qf[d0], s0); s1 = mfma32(k1, qf[d0], s1);
                }
                if (MODE == 2 && need_mask) {
#pragma unroll
                    for (int i = 0; i < 16; ++i) {
                        const int e0 = 16 * (i >> 3) + (i & 7), e1 = e0 + 32;
                        if (!(e0 <= rel && e0 > rel - 128)) s0[i] = NEG_INF;
                        if (!(e1 <= rel && e1 > rel - 128)) s1[i] = NEG_INF;
                    }
                }
                softmax_step(s0, s1, m[0], l[0], O[0][0], O[0][1]);
#pragma unroll
                for (int c2 = 0; c2 < 4; ++c2) {
                    const bf16x8 pf = pack8(c2 < 2 ? s0 : s1, c2 & 1);
                    const bf16x8 v0 = *(const bf16x8*)(vb_ + voff[c2]), v1 = *(const bf16x8*)(vb_ + voff[c2] + 4096);
                    O[0][0] = mfma32(v0, pf, O[0][0]); O[0][1] = mfma32(v1, pf, O[0][1]);
                }
            } else if (MODE == 1) {
                bf16x8 pa[4];
                {
                    f32x16 s0, s1;
                    const float c0 = sm_init(m[0]);
#pragma unroll
                    for (int i = 0; i < 16; ++i) { s0[i] = c0; s1[i] = c0; }
#pragma unroll
                    for (int d0 = 0; d0 < 2; ++d0) {
                        const bf16x8 k0 = *(const bf16x8*)(kb_ + koff[d0]), k1 = *(const bf16x8*)(kb_ + 4096 + koff[d0]);
                        s0 = mfma32(k0, qf[d0], s0); s1 = mfma32(k1, qf[d0], s1);
                    }
                    if (need_mask) {
#pragma unroll
                        for (int i = 0; i < 16; ++i) {
                            const int e0 = 16 * (i >> 3) + (i & 7), e1 = e0 + 32;
                            if (!(e0 <= rel)) s0[i] = NEG_INF;
                            if (!(e1 <= rel)) s1[i] = NEG_INF;
                        }
                    }
                    softmax_step(s0, s1, m[0], l[0], O[0][0], O[0][1]);
#pragma unroll
                    for (int c2 = 0; c2 < 4; ++c2) pa[c2] = pack8(c2 < 2 ? s0 : s1, c2 & 1);
                }
                __builtin_amdgcn_sched_barrier(0);
                f32x16 b0, b1;
                {
                    const float c1 = sm_init(m[1]);
#pragma unroll
                    for (int i = 0; i < 16; ++i) { b0[i] = c1; b1[i] = c1; }
                }
#pragma unroll
                for (int d0 = 2; d0 < 4; ++d0) {
                    const bf16x8 k0 = *(const bf16x8*)(kb_ + koff[d0]), k1 = *(const bf16x8*)(kb_ + 4096 + koff[d0]);
                    b0 = mfma32(k0, qf[d0], b0); b1 = mfma32(k1, qf[d0], b1);
                }
#pragma unroll
                for (int c2 = 0; c2 < 4; ++c2) {
                    const bf16x8 v0 = *(const bf16x8*)(vb_ + voff[c2]), v1 = *(const bf16x8*)(vb_ + voff[c2] + 4096);
                    O[0][0] = mfma32(v0, pa[c2], O[0][0]); O[0][1] = mfma32(v1, pa[c2], O[0][1]);
                }
                __builtin_amdgcn_sched_barrier(0);
                if (need_mask) {
#pragma unroll
                    for (int i = 0; i < 16; ++i) {
                        const int e0 = 16 * (i >> 3) + (i & 7), e1 = e0 + 32;
                        if (!(e0 <= rel)) b0[i] = NEG_INF;
                        if (!(e1 <= rel)) b1[i] = NEG_INF;
                    }
                }
                softmax_step(b0, b1, m[1], l[1], O[1][0], O[1][1]);
#pragma unroll
                for (int c2 = 0; c2 < 4; ++c2) {
                    const bf16x8 pf = pack8(c2 < 2 ? b0 : b1, c2 & 1);
                    const bf16x8 v0 = *(const bf16x8*)(vb_ + voff[c2]), v1 = *(const bf16x8*)(vb_ + voff[c2] + 4096);
                    O[1][0] = mfma32(v0, pf, O[1][0]); O[1][1] = mfma32(v1, pf, O[1][1]);
                }
            } else {
                f32x16 s[2];
#pragma unroll
                for (int i = 0; i < 16; ++i) { s[0][i] = 0.f; s[1][i] = 0.f; }
#pragma unroll
                for (int d0 = 0; d0 < 4; ++d0) {
                    const bf16x8 k0 = *(const bf16x8*)(kb_ + koff[d0]), k1 = *(const bf16x8*)(kb_ + 4096 + koff[d0]);
                    s[0] = mfma32(k0, qf[d0], s[0]); s[1] = mfma32(k1, qf[d0], s[1]);
                }
                float T[4];
#pragma unroll
                for (int g = 0; g < 4; ++g) {
                    float run = 0.f;
#pragma unroll
                    for (int e = 7; e >= 0; --e) {
                        const int idx = (g & 1) * 8 + e;
                        const float z = s[g >> 1][idx];
                        const float sp = fmaxf(z, 0.f) + lg2(1.f + ex2(-fabsf(z)));
                        const bool valid = !need_mask || (16 * g + e < rel);
                        const float L = valid ? -sp : 0.f;
                        s[g >> 1][idx] = valid ? (z + L + run) : NEG_INF;
                        run += L;
                    }
                    T[g] = run;
                }
                float Hs[4]; float accs = 0.f;
#pragma unroll
                for (int g = 3; g >= 0; --g) {
                    const float To = xhalf(T[g]);
                    Hs[g] = accs + (hi == 0 ? To : 0.f);
                    accs += T[g] + To;
                }
#pragma unroll
                for (int g = 0; g < 4; ++g) {
                    const float off = Hs[g] + carry;
#pragma unroll
                    for (int e = 0; e < 8; ++e) { const int idx = (g & 1) * 8 + e; s[g >> 1][idx] = ex2(s[g >> 1][idx] + off); }
                }
                carry += accs;
#pragma unroll
                for (int c2 = 0; c2 < 4; ++c2) {
                    const bf16x8 pf = pack8(c2 < 2 ? s[0] : s[1], c2 & 1);
                    const bf16x8 v0 = *(const bf16x8*)(vb_ + voff[c2]), v1 = *(const bf16x8*)(vb_ + voff[c2] + 4096);
                    O[0][0] = mfma32(v0, pf, O[0][0]); O[0][1] = mfma32(v1, pf, O[0][1]);
                }
            }
        }
        if (MODE == 0) {
            const bool wdone = __all(carry < -160.f);
            if (lane == 0) misc[4 + (it & 1) * 8 + wid] = wdone ? 1 : 0;
        }
        if (it + 1 < nt) {
            char* nb = lds + ((it + 1) & 1) * 8192;
            *(u32x4*)(nb + so) = rk0;
            *(u32x4*)(nb + 16384 + so) = rv0;
        }
        __syncthreads();
        if (MODE == 0) {
            const int* f = misc + 4 + (it & 1) * 8;
            if (f[0] & f[1] & f[2] & f[3] & f[4] & f[5] & f[6] & f[7]) break;
        }
    }

    if (MODE == 3) {
        const float inv = 1.f / (l[0] + xhalf(l[0]));
#pragma unroll
        for (int i = 0; i < 16; ++i) { O[0][0][i] *= inv; O[0][1][i] *= inv; }
    } else if (MODE == 2) {
        const float lt = l[0] + xhalf(l[0]);
        const float sk = p.sinks[head] * LOG2E;
        const float mf = fmaxf(m[0], sk);
        const float a = ex2(m[0] - mf);
        const float f = a / (lt * a + ex2(sk - mf));
#pragma unroll
        for (int i = 0; i < 16; ++i) { O[0][0][i] *= f; O[0][1][i] *= f; }
    } else if (MODE == 1) {
        const float i1 = 1.f / (l[0] + xhalf(l[0])), i2 = lam / (l[1] + xhalf(l[1]));
        float ss = 0.f;
#pragma unroll
        for (int i = 0; i < 16; ++i) {
            O[0][0][i] = O[0][0][i] * i1 - O[1][0][i] * i2; O[0][1][i] = O[0][1][i] * i1 - O[1][1][i] * i2;
            ss += O[0][0][i] * O[0][0][i] + O[0][1][i] * O[0][1][i];
        }
        ss += xhalf(ss);
        const float rn = 0.8f / sqrtf(ss * (1.f / 64.f) + LN_EPS);
#pragma unroll
        for (int dh = 0; dh < 2; ++dh)
#pragma unroll
            for (int g = 0; g < 4; ++g) {
                const f32x4 sg = *(const f32x4*)(p.subln + dh * 32 + g * 8 + hi * 4);
#pragma unroll
                for (int r = 0; r < 4; ++r) O[0][dh][4 * g + r] *= rn * sg[r];
            }
    }
#pragma unroll
    for (int dh = 0; dh < 2; ++dh)
#pragma unroll
        for (int g = 0; g < 4; ++g) {
            const int d = dh * 32 + g * 8 + hi * 4;
            const u32x2 gg = *(const u32x2*)(gp + (long)trow * hw + d);
            u32x2 w;
            w.x = cvt_pk(O[0][dh][4 * g + 0] * bflo(gg.x), O[0][dh][4 * g + 1] * bfhi(gg.x));
            w.y = cvt_pk(O[0][dh][4 * g + 2] * bflo(gg.y), O[0][dh][4 * g + 3] * bfhi(gg.y));
            *(u32x2*)(op + (long)trow * 1024 + d) = w;
        }
}

DI void attn_phase_even(const Params& p, char* lds) {
    float lam;
    {
        float a = 0.f, c = 0.f;
        for (int i = 0; i < 32; ++i) { a += p.dlam[i] * p.dlam[32 + i]; c += p.dlam[64 + i] * p.dlam[96 + i]; }
        lam = expf(a) - expf(c) + 0.2f;
    }
    int* misc = (int*)(lds + 32768);
    for (;;) {
        __syncthreads();
        if (threadIdx.x == 0) misc[0] = (int)atomicAdd(p.ctr + 0, 1u);
        __syncthreads();
        const int item = misc[0];
        if (item >= 1024) break;
        if (item < 384) { const int qb = 31 - item / 12, bh = item % 12; attn_item<1>(p, lds, bh / 6, bh % 6, qb, 0, lam); }
        else if (item < 768) { const int u = item - 384; const int qb = 31 - u / 12, bh = u % 12; attn_item<0>(p, lds, bh / 6, bh % 6, qb, 0, lam); }
        else { const int u = item - 768; const int qb = u >> 3, bh = u & 7; attn_item<3>(p, lds, bh >> 2, bh & 3, qb, 0, lam); }
    }
}

DI void attn_phase_odd(const Params& p, char* lds) {
    int* misc = (int*)(lds + 32768);
    for (;;) {
        __syncthreads();
        if (threadIdx.x == 0) misc[0] = (int)atomicAdd(p.ctr + 1, 1u);
        __syncthreads();
        const int item = misc[0];
        if (item >= 1024) break;
        if (item < 768) { const int qb = item / 6, r = item % 6; attn_item<2>(p, lds, r / 3, r % 3, qb, 1, 0.f); }
        else { const int u = item - 768; const int qb = u >> 3, bh = u & 7; attn_item<3>(p, lds, bh >> 2, bh & 3, qb, 1, 0.f); }
    }
}

#define XB_TMO      128
#define XB_XCNT(j)  (256  + 64 * (j))
#define XB_XSUB(j)  (1280 + 64 * (j))
#define XB_XGEN(j)  (2304 + 64 * (j))
#define XB_TOP      3328
#define XB_TOPGEN   3392
#define XCD_BAR_WORDS 3456
#define XB_SPIN_CAP (1u << 18)
DI unsigned xb_ld(unsigned* p)              { return __hip_atomic_load(p, __ATOMIC_RELAXED, __HIP_MEMORY_SCOPE_AGENT); }
DI unsigned xb_add(unsigned* p, unsigned v) { return __hip_atomic_fetch_add(p, v, __ATOMIC_RELAXED, __HIP_MEMORY_SCOPE_AGENT); }
DI unsigned xb_xcc_id() { return (unsigned)__builtin_amdgcn_s_getreg((3 << 11) | 20) & 0xFu; }
#define XB_SPIN(cond, bar) do { unsigned _sp = 0; while (cond) { __builtin_amdgcn_s_sleep(0); \
    if ((++_sp & 255u) == 0u) { if (xb_ld(&(bar)[XB_TMO])) break; if (_sp > XB_SPIN_CAP) { atomicAdd(&(bar)[XB_TMO], 1u); break; } } } } while (0)
struct XcdBarrier { unsigned* bar; unsigned x; };
DI XcdBarrier xcd_barrier_post(unsigned* bar) {
    XcdBarrier b; b.bar = bar; b.x = xb_xcc_id();
    if (threadIdx.x == 0) (void)xb_add(&bar[XB_XCNT(b.x)], 1u);
    return b;
}
DI void xcd_barrier_complete(unsigned* bar, unsigned x, unsigned& nloc, unsigned& nx) {
    const unsigned G = gridDim.x * gridDim.y * gridDim.z;
    unsigned sum, cnt, mine, sp = 0u;
    for (;;) {
        sum = 0u; cnt = 0u; mine = 0u;
#pragma unroll
        for (unsigned j = 0; j < 16; ++j) { const unsigned c = xb_ld(&bar[XB_XCNT(j)]); sum += c; cnt += (c > 0u) ? 1u : 0u; mine = (j == x) ? c : mine; }
        if (sum == G) break;
        __builtin_amdgcn_s_sleep(1);
        if ((++sp & 255u) == 0u) { if (xb_ld(&bar[XB_TMO])) break; if (sp > XB_SPIN_CAP) { atomicAdd(&bar[XB_TMO], 1u); break; } }
    }
    nloc = mine > 0u ? mine : 1u; nx = cnt > 0u ? cnt : 1u;
}
DI void xcd_barrier(const XcdBarrier& b, volatile unsigned* st) {
    asm volatile("s_waitcnt vmcnt(0)" ::: "memory");
    __syncthreads();
    if (threadIdx.x == 0) {
        unsigned* bar = b.bar;
        __builtin_amdgcn_s_waitcnt(0);
        unsigned nloc = st[0], nx = st[1];
        if (nloc == 0u) { xcd_barrier_complete(bar, b.x, nloc, nx); st[0] = nloc; st[1] = nx; }
        const unsigned old = xb_add(&bar[XB_XSUB(b.x)], 1u);
        const unsigned gen = old / nloc;
        if (old + 1u == (gen + 1u) * nloc) {
            __builtin_amdgcn_fence(__ATOMIC_RELEASE, "agent");
            asm volatile("s_waitcnt vmcnt(0)" ::: "memory");
            const unsigned og = xb_add(&bar[XB_TOP], 1u);
            const unsigned tg = og / nx;
            if (og + 1u == (tg + 1u) * nx) xb_add(&bar[XB_TOPGEN], 1u);
            else XB_SPIN(xb_ld(&bar[XB_TOPGEN]) == tg, bar);
            __builtin_amdgcn_fence(__ATOMIC_ACQUIRE, "agent");
            xb_add(&bar[XB_XGEN(b.x)], 1u);
            asm volatile("s_waitcnt vmcnt(0)" ::: "memory");
        } else {
            XB_SPIN(xb_ld(&bar[XB_XGEN(b.x)]) == gen, bar);
            __builtin_amdgcn_fence(__ATOMIC_ACQUIRE, "agent");
            asm volatile("s_waitcnt vmcnt(0)" ::: "memory");
        }
    }
    __syncthreads();
}

template <bool COOP>
__global__ void __launch_bounds__(512, 2) mega(Params p, int ph_lo, int ph_hi) {
    extern __shared__ __attribute__((aligned(16))) char lds_dyn[];
    char* lds = lds_dyn + (threadIdx.x >> 8) * 65536;
    if (threadIdx.x == 0) { ((volatile unsigned*)(lds_dyn + 131072))[0] = 0u; ((volatile unsigned*)(lds_dyn + 131072))[1] = 0u; }
    const XcdBarrier xb = xcd_barrier_post(p.bar);
    if (COOP && ph_hi == 0x7fffffff) cg::this_grid().sync();
#define PHASE(k, body) if (ph_lo <= (k) && (k) < ph_hi) { if (COOP && (k) > ph_lo) xcd_barrier(xb, (volatile unsigned*)(lds_dyn + 131072)); body; }
    PHASE(0, phase_prep(p, lds))
    PHASE(1, gemm_phase_inproj_even(p, lds_dyn))
    PHASE(2, attn_phase_even(p, lds_dyn))
    PHASE(3, gemm_phase_outproj_ln(p, p.WoutE, p.x, p.lng_e, p.lnb_e, true, 0, lds_dyn))
    PHASE(5, gemm_phase_inproj_odd(p, lds_dyn))
    PHASE(6, attn_phase_odd(p, lds_dyn))
    PHASE(7, gemm_phase_outproj_ln(p, p.WoutO, p.out, p.lng_o, p.lnb_o, false, 1, lds_dyn))
#undef PHASE
}

extern "C" void kernel_launch(void* const* d_in, const int* in_sizes, int n_in, void* d_out, int out_size, void* d_ws, size_t ws_size, hipStream_t stream) {
    Params p{};
    p.x = (const float*)d_in[0]; p.mem = (const float*)d_in[1]; p.pos = (const int*)d_in[2];
    p.w_in_e = (const float*)d_in[3]; p.w_mkv_e = (const float*)d_in[4]; p.dlam = (const float*)d_in[5]; p.subln = (const float*)d_in[6];
    p.w_out_e = (const float*)d_in[7]; p.lng_e = (const float*)d_in[8]; p.lnb_e = (const float*)d_in[9];
    p.w_in_o = (const float*)d_in[10]; p.w_mkv_o = (const float*)d_in[11]; p.sinks = (const float*)d_in[12]; p.w_out_o = (const float*)d_in[13];
    p.lng_o = (const float*)d_in[14]; p.lnb_o = (const float*)d_in[15];
    p.out = (float*)d_out;
    char* w = (char*)d_ws; size_t o = 0;
    auto take = [&](size_t bytes) { char* r = w + o; o += (bytes + 255) & ~(size_t)255; return r; };
    p.xb = (bf16_t*)take((size_t)NTOK * DM * 2);
    p.H = (bf16_t*)take((size_t)NTOK * HWE * 2);
    p.VT = (bf16_t*)take((size_t)NB * 768 * SEQ * 2);
    p.G = (bf16_t*)take((size_t)NTOK * DM * 2);
    p.WinE = (bf16_t*)take((size_t)HWE * 1024 * 2);
    p.WoutE = (bf16_t*)take((size_t)1024 * 1024 * 2);
    p.WinO = (bf16_t*)take((size_t)HWO * 1024 * 2);
    p.WoutO = (bf16_t*)take((size_t)1024 * 1024 * 2);
    p.Wmkv = (bf16_t*)take((size_t)2 * 512 * 1024 * 2);
    p.memb = (bf16_t*)take((size_t)512 * 1024 * 2);
    p.MK = (bf16_t*)take((size_t)2 * 512 * 256 * 2);
    p.MVT = (bf16_t*)take((size_t)2 * 2 * 256 * 256 * 2);
    p.rope = (float*)take((size_t)NTOK * 16 * 4);
    p.lnx = (unsigned long long*)take((size_t)2 * NTOK * 4 * 8);
    p.ctr = (unsigned*)take(1024);
    p.bar = (unsigned*)take(XCD_BAR_WORDS * 4);

    static int grid = 0;
    if (!grid) {
        int dev = 0, cus = 0, per = 0;
        hipGetDevice(&dev);
        hipDeviceGetAttribute(&cus, hipDeviceAttributeMultiprocessorCount, dev);
        hipFuncSetAttribute((const void*)mega<true>, hipFuncAttributeMaxDynamicSharedMemorySize, 131072 + 256);
        hipOccupancyMaxActiveBlocksPerMultiprocessor(&per, mega<true>, 512, 131072 + 256);
        if (per > 1) per = 1;
        if (per < 1) per = 1;
        grid = cus * per;
        if (grid != 256) fprintf(stderr, "this kernel expects a 256-workgroup cooperative grid (got %d): the fused LayerNorm exchange needs one out-projection tile per workgroup\n", grid);
    }
    hipMemsetAsync(p.ctr, 0, 1024 + XCD_BAR_WORDS * 4, stream);
    int lo = 0, hi = 9;
    void* args[] = {&p, &lo, &hi};
    hipError_t e = hipLaunchCooperativeKernel((void*)mega<true>, dim3(grid), dim3(512), args, 131072 + 256, stream);
    if (e != hipSuccess) fprintf(stderr, "cooperative launch failed: %s (grid %d)\n", hipGetErrorString(e), grid);
}
```
